# Optimizing an MI355X kernel written in HIP

```python
import jax, jax.numpy as jnp
from jax import lax
import numpy as np

D_MODEL = 1024
BATCH = 2
SEQ = 16384
DEPTH = 2

D_MIX = D_MODEL
EPS = 1e-6
GLA_HEADS = 4
GLA_DK = D_MODEL // 32
GLA_DV = D_MODEL // 16
GLA_QK = GLA_HEADS * GLA_DK
GLA_W = GLA_HEADS * GLA_DV
GLA_RANK = 16
GLA_TAU = 16.0
GLA_CHUNK = 64
FNET_GROUPS = 4
FNET_DG = D_MODEL // 16
FNET_W = FNET_GROUPS * FNET_DG
MLA_HEADS = 8
MLA_NOPE = D_MODEL // 16
MLA_ROPE = D_MODEL // 32
MLA_V = D_MODEL // 16
MLA_Q_RANK = D_MODEL // 4
MLA_KV_RANK = D_MODEL // 8
MLA_W = MLA_HEADS * MLA_V
ROPE_THETA = 10000.0
Q_BLOCK = 128
IN_SPLITS = (GLA_QK, GLA_QK, GLA_W, GLA_W, GLA_RANK, GLA_RANK, FNET_W, MLA_Q_RANK, MLA_KV_RANK, MLA_ROPE)
IN_WIDTH = GLA_QK * 2 + GLA_W * 2 + GLA_RANK * 2 + FNET_W + MLA_Q_RANK + MLA_KV_RANK + MLA_ROPE
N_GROUPS = 4
EXPERTS_PER_GROUP = 8
N_EXPERTS = N_GROUPS * EXPERTS_PER_GROUP
TOP_K = 2
D_EXPERT = D_MODEL // 4

kernel_name = "hybrid_gla_fnet_mla_hmoe_encoder"


def rms_norm(x, g):
    xf = x.astype(jnp.float32)
    y = xf * lax.rsqrt(jnp.mean(xf * xf, axis=-1, keepdims=True) + EPS)
    return (y * g.astype(jnp.float32)).astype(x.dtype)


def rope_tables(positions):
    inv = 1.0 / (ROPE_THETA ** (jnp.arange(0, MLA_ROPE, 2, dtype=jnp.float32) / MLA_ROPE))
    ang = positions.astype(jnp.float32)[..., None] * inv
    return jnp.cos(ang), jnp.sin(ang)


def apply_rope(x, cos, sin):
    x1, x2 = jnp.split(x.astype(jnp.float32), 2, axis=-1)
    return jnp.concatenate([x1 * cos - x2 * sin, x1 * sin + x2 * cos], axis=-1).astype(x.dtype)


def gla_direction(q, k, v, log_a, inclusive):
    B, S, H, dk = q.shape
    dv = v.shape[-1]
    C = GLA_CHUNK
    N = S // C
    f32 = jnp.float32
    qc = q.astype(f32).reshape(B, N, C, H, dk)
    kc = k.astype(f32).reshape(B, N, C, H, dk)
    vc = v.astype(f32).reshape(B, N, C, H, dv)
    b = jnp.cumsum(log_a.reshape(B, N, C, H, dk), axis=2)
    b_last = b[:, :, -1]
    q_dec = qc * jnp.exp(b)
    k_inv = kc * jnp.exp(-b)
    k_end = kc * jnp.exp(b_last[:, :, None] - b)
    mask = jnp.tril(jnp.ones((C, C), dtype=bool), 0 if inclusive else -1)
    att = jnp.where(mask, jnp.einsum('bnihd,bnjhd->bnhij', q_dec, k_inv), 0.0)
    o_intra = jnp.einsum('bnhij,bnjhv->bnihv', att, vc)
    kv = jnp.einsum('bnjhd,bnjhv->nbhdv', k_end, vc)
    decay = jnp.exp(b_last).transpose(1, 0, 2, 3)

    def step(state, inp):
        kv_n, dec_n = inp
        return dec_n[..., None] * state + kv_n, state

    _, s_prev = lax.scan(step, jnp.zeros((B, H, dk, dv), f32), (kv, decay))
    o_inter = jnp.einsum('bnihd,nbhdv->bnihv', q_dec, s_prev)
    return (o_intra + o_inter).reshape(B, S, H, dv)


def gla_mixer(q, k, v, g, a_f, a_b, wa_f, ba_f, wa_b, ba_b, norm_g):
    B, S, _ = q.shape
    qh = q.reshape(B, S, GLA_HEADS, GLA_DK) * (GLA_DK ** -0.5)
    kh = k.reshape(B, S, GLA_HEADS, GLA_DK)
    vh = v.reshape(B, S, GLA_HEADS, GLA_DV)
    log_af = (jax.nn.log_sigmoid((a_f @ wa_f + ba_f).astype(jnp.float32)) / GLA_TAU).reshape(B, S, GLA_HEADS, GLA_DK)
    log_ab = (jax.nn.log_sigmoid((a_b @ wa_b + ba_b).astype(jnp.float32)) / GLA_TAU).reshape(B, S, GLA_HEADS, GLA_DK)
    o_f = gla_direction(qh, kh, vh, log_af, True)
    o_b = jnp.flip(gla_direction(jnp.flip(qh, 1), jnp.flip(kh, 1), jnp.flip(vh, 1), jnp.flip(log_ab, 1), False), 1)
    o = rms_norm(o_f + o_b, norm_g).reshape(B, S, GLA_W)
    return (o * jax.nn.silu(g.astype(jnp.float32))).astype(q.dtype)


def fnet_mixer(u, w_mix):
    B, S, _ = u.shape
    uf = u.astype(jnp.float32).reshape(B, S, FNET_GROUPS, FNET_DG)
    f = jnp.fft.fft2(uf, axes=(1, 3), norm='ortho').real
    y = jnp.einsum('bsgc,gcd->bsgd', f, w_mix.astype(jnp.float32))
    return y.reshape(B, S, FNET_W).astype(u.dtype)


def mla_mixer(c_q, c_kv, k_r, cos, sin, q_norm_g, w_uq, kv_norm_g, w_ukv):
    B, S, _ = c_q.shape
    q = (rms_norm(c_q, q_norm_g) @ w_uq).reshape(B, S, MLA_HEADS, MLA_NOPE + MLA_ROPE)
    q_nope = q[..., :MLA_NOPE]
    q_rope = apply_rope(q[..., MLA_NOPE:], cos[:, :, None], sin[:, :, None])
    kv = (rms_norm(c_kv, kv_norm_g) @ w_ukv).reshape(B, S, MLA_HEADS, MLA_NOPE + MLA_V)
    k_nope = kv[..., :MLA_NOPE]
    v = kv[..., MLA_NOPE:]
    k_rope = apply_rope(k_r, cos, sin)
    scale = (MLA_NOPE + MLA_ROPE) ** -0.5
    nb = S // Q_BLOCK
    qn_blocks = q_nope.reshape(B, nb, Q_BLOCK, MLA_HEADS, MLA_NOPE).transpose(1, 0, 2, 3, 4)
    qr_blocks = q_rope.reshape(B, nb, Q_BLOCK, MLA_HEADS, MLA_ROPE).transpose(1, 0, 2, 3, 4)

    def attend(blk):
        qn, qr = blk
        s = (jnp.einsum('bqhd,bkhd->bhqk', qn, k_nope, preferred_element_type=jnp.float32)
             + jnp.einsum('bqhr,bkr->bhqk', qr, k_rope, preferred_element_type=jnp.float32)) * scale
        p = jax.nn.softmax(s, axis=-1)
        return jnp.einsum('bhqk,bkhv->bqhv', p.astype(v.dtype), v)

    o = lax.map(attend, (qn_blocks, qr_blocks))
    return o.transpose(1, 0, 2, 3, 4).reshape(B, S, MLA_W)


def hier_moe(h, w_rg, b_rg, w_re, b_re, w_gate, w_up, w_down):
    B, S, D = h.shape
    t = h.reshape(B * S, D)
    f32 = jnp.float32
    grp_p = jax.nn.softmax((t @ w_rg + b_rg).astype(f32), axis=-1)
    grp_w, grp_idx = lax.top_k(grp_p, 1)
    exp_logits = (t @ w_re + b_re).astype(f32).reshape(-1, N_GROUPS, EXPERTS_PER_GROUP)
    in_grp = jnp.einsum('tg,tge->te', jax.nn.one_hot(grp_idx[:, 0], N_GROUPS, dtype=f32), exp_logits)
    e_w, e_idx = lax.top_k(jax.nn.softmax(in_grp, axis=-1), TOP_K)
    e_w = e_w / jnp.sum(e_w, axis=-1, keepdims=True)
    expert_id = grp_idx * EXPERTS_PER_GROUP + e_idx
    combine = jnp.sum(jax.nn.one_hot(expert_id, N_EXPERTS, dtype=f32) * (grp_w * e_w)[..., None], axis=1)
    y = jnp.zeros(t.shape, f32)
    for e in range(N_EXPERTS):
        he = jax.nn.silu(t @ w_gate[e]) * (t @ w_up[e])
        y = y + combine[:, e:e + 1] * (he @ w_down[e]).astype(f32)
    return y.reshape(B, S, D).astype(h.dtype)


def setup_inputs(seed: int = 0) -> dict:
    key = jax.random.key(seed)
    ks = jax.random.split(key, 32)
    nrm = lambda k, shape, s: jax.random.normal(k, shape, jnp.float32) * s
    gain = lambda k, shape: 1.0 + 0.02 * jax.random.normal(k, shape, jnp.float32)
    L = DEPTH
    x = jax.random.normal(ks[0], (BATCH, SEQ, D_MODEL), jnp.float32)
    positions = (jnp.arange(SEQ, dtype=jnp.int32)[None, :]
                 + jax.random.randint(ks[1], (BATCH, 1), 0, 1024, dtype=jnp.int32))
    return {
        "x": x,
        "positions": positions,
        "norm1_g": gain(ks[2], (L, D_MODEL)),
        "w_in": nrm(ks[3], (L, D_MODEL, IN_WIDTH), D_MODEL ** -0.5),
        "gla_wa_f": nrm(ks[4], (L, GLA_RANK, GLA_QK), GLA_RANK ** -0.5),
        "gla_ba_f": nrm(ks[5], (L, GLA_QK), 0.1),
        "gla_wa_b": nrm(ks[6], (L, GLA_RANK, GLA_QK), GLA_RANK ** -0.5),
        "gla_ba_b": nrm(ks[7], (L, GLA_QK), 0.1),
        "gla_norm_g": gain(ks[8], (L, GLA_DV)),
        "fnet_w": nrm(ks[9], (L, FNET_GROUPS, FNET_DG, FNET_DG), FNET_DG ** -0.5),
        "mla_q_norm_g": gain(ks[10], (L, MLA_Q_RANK)),
        "mla_w_uq": nrm(ks[11], (L, MLA_Q_RANK, MLA_HEADS * (MLA_NOPE + MLA_ROPE)), MLA_Q_RANK ** -0.5),
        "mla_kv_norm_g": gain(ks[12], (L, MLA_KV_RANK)),
        "mla_w_ukv": nrm(ks[13], (L, MLA_KV_RANK, MLA_HEADS * (MLA_NOPE + MLA_V)), MLA_KV_RANK ** -0.5),
        "w_out": nrm(ks[14], (L, D_MIX, D_MODEL), D_MIX ** -0.5),
        "norm2_g": gain(ks[15], (L, D_MODEL)),
        "moe_w_rg": nrm(ks[16], (L, D_MODEL, N_GROUPS), D_MODEL ** -0.5),
        "moe_b_rg": nrm(ks[17], (L, N_GROUPS), 0.01),
        "moe_w_re": nrm(ks[18], (L, D_MODEL, N_EXPERTS), D_MODEL ** -0.5),
        "moe_b_re": nrm(ks[19], (L, N_EXPERTS), 0.01),
        "moe_w_gate": nrm(ks[20], (L, N_EXPERTS, D_MODEL, D_EXPERT), D_MODEL ** -0.5),
        "moe_w_up": nrm(ks[21], (L, N_EXPERTS, D_MODEL, D_EXPERT), D_MODEL ** -0.5),
        "moe_w_down": nrm(ks[22], (L, N_EXPERTS, D_EXPERT, D_MODEL), D_EXPERT ** -0.5),
        "final_norm_g": gain(ks[23], (D_MODEL,)),
    }


def reference(x, positions, norm1_g, w_in, gla_wa_f, gla_ba_f, gla_wa_b, gla_ba_b, gla_norm_g, fnet_w,
              mla_q_norm_g, mla_w_uq, mla_kv_norm_g, mla_w_ukv, w_out, norm2_g, moe_w_rg, moe_b_rg,
              moe_w_re, moe_b_re, moe_w_gate, moe_w_up, moe_w_down, final_norm_g):
    cos, sin = rope_tables(positions)
    split_at = [int(i) for i in np.cumsum(IN_SPLITS)[:-1]]
    for l in range(DEPTH):
        xn = rms_norm(x, norm1_g[l])
        proj = xn @ w_in[l]
        gq, gk, gv, gg, gaf, gab, fu, cq, ckv, kr = jnp.split(proj, split_at, axis=-1)
        o_gla = gla_mixer(gq, gk, gv, gg, gaf, gab, gla_wa_f[l], gla_ba_f[l], gla_wa_b[l], gla_ba_b[l], gla_norm_g[l])
        o_fnet = fnet_mixer(fu, fnet_w[l])
        o_mla = mla_mixer(cq, ckv, kr, cos, sin, mla_q_norm_g[l], mla_w_uq[l], mla_kv_norm_g[l], mla_w_ukv[l])
        x = x + jnp.concatenate([o_gla, o_fnet, o_mla], axis=-1) @ w_out[l]
        x = x + hier_moe(rms_norm(x, norm2_g[l]), moe_w_rg[l], moe_b_rg[l], moe_w_re[l], moe_b_re[l],
                         moe_w_gate[l], moe_w_up[l], moe_w_down[l])
    return rms_norm(x, final_norm_g)
```

```cpp
#include <hip/hip_runtime.h>
#include <cstdio>
#include <cstdint>

#define GAS __attribute__((address_space(1)))
#define LAS __attribute__((address_space(3)))
typedef unsigned short bf16_t;
typedef short bf16x8 __attribute__((ext_vector_type(8)));
typedef short s16x4 __attribute__((ext_vector_type(4)));
typedef float f32x2 __attribute__((ext_vector_type(2)));
typedef float f32x4 __attribute__((ext_vector_type(4)));
typedef float f32x16 __attribute__((ext_vector_type(16)));
typedef unsigned u32x2 __attribute__((ext_vector_type(2)));
typedef unsigned u32x4 __attribute__((ext_vector_type(4)));

constexpr int DM = 1024, BATCH = 2, SEQ = 16384, T = BATCH * SEQ, DEPTH = 2;
constexpr int IN_W = 1472;
constexpr int PW = 1792;
constexpr int PC_GQ = 0, PC_GK = 128, PC_GV = 256, PC_GG = 512, PC_Z = 768, PC_CQ = 1280, PC_CKV = 1536, PC_KR = 1664, PC_AF = 1696, PC_AB = 1712, PC_PAD = 1728;
constexpr int RC_GQ = 0, RC_GK = 128, RC_GV = 256, RC_GG = 512, RC_AF = 768, RC_AB = 784, RC_FU = 800, RC_CQ = 1056, RC_CKV = 1312, RC_KR = 1440;
constexpr int NH = 8, QKD = 96, QW = NH * QKD  , KVW = 1024;
constexpr float EPS = 1e-6f;
constexpr float C2 = 0.10206207261596577f * 1.4426950408889634f;
constexpr int NEXP = 32, DEXP = 256;
constexpr int MS_MAX = 2 * T + NEXP * 256;
constexpr int MT_MAX = MS_MAX / 256;
constexpr int NCHUNK = SEQ / 64;

constexpr size_t MiB = 1u << 20, KiB = 1024;
constexpr size_t WS_CTL = 0, CTL_ZERO_BYTES = 64 * KiB;
constexpr size_t WS_FM = 1 * MiB;
constexpr size_t WS_DFTW = WS_FM + 256 * KiB;
constexpr size_t WS_WR = WS_DFTW + 96 * KiB;
constexpr size_t WS_ROPE = 2 * MiB;
constexpr size_t WS_WIN = 6 * MiB;
constexpr size_t WS_WOUT = 13 * MiB;
constexpr size_t WS_WUQ = 17 * MiB;
constexpr size_t WS_WUKV = 18 * MiB;
constexpr size_t WS_EID = 19 * MiB;
constexpr size_t WS_EW = WS_EID + 256 * KiB;
constexpr size_t WS_RS2 = WS_EW + 256 * KiB;
constexpr size_t WS_RSQ = WS_RS2 + 128 * KiB;
constexpr size_t WS_RSKV = WS_RSQ + 128 * KiB;
constexpr size_t WS_CNT = WS_RSKV + 128 * KiB;
constexpr size_t WS_SRC = WS_CNT + 32 * KiB;
constexpr size_t WS_WGT = WS_SRC + 288 * KiB;
constexpr size_t WS_TILEE = WS_WGT + 288 * KiB;
constexpr size_t WS_DEC = WS_TILEE + 4 * KiB;
constexpr size_t WS_ROWTOK = WS_DEC + 512 * KiB;
static_assert(WS_ROWTOK + 288 * KiB <= 22 * MiB, "tables");
constexpr size_t WS_X1 = 22 * MiB;
constexpr size_t WS_XN = 150 * MiB;
constexpr size_t WS_P = 214 * MiB;
constexpr size_t WS_Q = 326 * MiB;
constexpr size_t WS_K8 = WS_Q + 24 * MiB;
constexpr size_t WS_KV = 374 * MiB;
constexpr size_t WS_V8T = WS_KV + 32 * MiB;
constexpr size_t WS_KR = 438 * MiB;
constexpr size_t WS_S = 440 * MiB;
constexpr size_t WS_YP = 472 * MiB;
constexpr size_t WS_HE = 294 * MiB;
constexpr size_t WS_Y = 330 * MiB;
constexpr size_t WS_WGU = 458 * MiB;
constexpr size_t WS_WD = 490 * MiB;
constexpr size_t WS_END = 506 * MiB;

#define LDS_WAIT() asm volatile("s_waitcnt lgkmcnt(0)" ::: "memory")
#define VM_WAIT() asm volatile("s_waitcnt vmcnt(0)" ::: "memory")
#define SBAR() __builtin_amdgcn_sched_barrier(0)
__device__ __forceinline__ unsigned f2bf(float f) { unsigned u = __builtin_bit_cast(unsigned, f); return (u + 0x7fffu + ((u >> 16) & 1u)) >> 16; }
__device__ __forceinline__ unsigned pk2(float lo, float hi) { return f2bf(lo) | (f2bf(hi) << 16); }
__device__ __forceinline__ float bf2f(unsigned short b) { return __builtin_bit_cast(float, (unsigned)b << 16); }
__device__ __forceinline__ float bflo(unsigned w) { return __builtin_bit_cast(float, w << 16); }
__device__ __forceinline__ float bfhi(unsigned w) { return __builtin_bit_cast(float, w & 0xffff0000u); }
__device__ __forceinline__ unsigned cvtpk(float lo, float hi) { unsigned r; asm volatile("v_cvt_pk_bf16_f32 %0, %1, %2" : "=v"(r) : "v"(lo), "v"(hi)); return r; }
__device__ __forceinline__ int crow(int r, int hi) { return (r & 3) + 8 * (r >> 2) + 4 * hi; }
__device__ __forceinline__ int ltid() { int t = threadIdx.x; asm volatile("" : "+v"(t)); return t; }
__device__ __forceinline__ int lbid() { int b = blockIdx.x; asm volatile("" : "+s"(b)); return b; }
__device__ __forceinline__ float shflx(float v, int o) { return __builtin_bit_cast(float, __builtin_amdgcn_ds_bpermute((((ltid() & 63) ^ o)) << 2, __builtin_bit_cast(int, v))); }
__device__ __forceinline__ float shfl_from(float v, int srclane) { return __builtin_bit_cast(float, __builtin_amdgcn_ds_bpermute(srclane << 2, __builtin_bit_cast(int, v))); }
__device__ __forceinline__ float wave_sum(float v) {
#pragma unroll
    for (int o = 1; o < 64; o <<= 1) v += shflx(v, o);
    return v;
}
typedef short v4i16_t __attribute__((ext_vector_type(4)));
__device__ __forceinline__ s16x4 vtr(const LAS unsigned char* p) { return __builtin_bit_cast(s16x4, __builtin_amdgcn_ds_read_tr16_b64_v4i16((LAS v4i16_t*)p)); }
__device__ __forceinline__ int tr_lane_off(int lane, int stride) { const int i = lane & 15; return ((lane >> 5) * 8 + (i >> 2)) * stride + (((lane >> 4) & 1) * 16 + (i & 3) * 4) * 2; }
__device__ __forceinline__ bf16x8 tr_frag(const LAS unsigned char* p, int stride) {
    const s16x4 a = vtr(p), b = vtr(p + 4 * stride);
    return (bf16x8){a[0], a[1], a[2], a[3], b[0], b[1], b[2], b[3]};
}
#define PK4(P, BASE, OUT) do { unsigned a0_ = cvtpk(P[BASE + 0], P[BASE + 1]), a1_ = cvtpk(P[BASE + 2], P[BASE + 3]);   \
    unsigned b0_ = cvtpk(P[BASE + 4], P[BASE + 5]), b1_ = cvtpk(P[BASE + 6], P[BASE + 7]);                              \
    auto r0_ = __builtin_amdgcn_permlane32_swap(a0_, b0_, false, false); auto r1_ = __builtin_amdgcn_permlane32_swap(a1_, b1_, false, false); \
    u32x4 w_ = {r0_[0], r1_[0], r0_[1], r1_[1]}; OUT = __builtin_bit_cast(bf16x8, w_); } while (0)

#define XB_TMO      128
#define XB_XCNT(j)  (256  + 64 * (j))
#define XB_XSUB(j)  (1280 + 64 * (j))
#define XB_XGEN(j)  (2304 + 64 * (j))
#define XB_TOP      3328
#define XB_TOPGEN   3392
#define XCD_BAR_WORDS 3456
#define XB_SPIN_CAP (1u << 22)

__device__ __forceinline__ unsigned xb_ld(unsigned* p)              { return __hip_atomic_load(p, __ATOMIC_RELAXED, __HIP_MEMORY_SCOPE_AGENT); }
__device__ __forceinline__ unsigned xb_add(unsigned* p, unsigned v) { return __hip_atomic_fetch_add(p, v, __ATOMIC_RELAXED, __HIP_MEMORY_SCOPE_AGENT); }
__device__ __forceinline__ unsigned xb_xcc_id() { return (unsigned)__builtin_amdgcn_s_getreg((3 << 11) | 20) & 0xFu; }
#define XB_SPIN(cond, bar) do { unsigned _sp = 0; while (cond) { __builtin_amdgcn_s_sleep(1); \
    if ((++_sp & 255u) == 0u) { if (xb_ld(&(bar)[XB_TMO])) break; if (_sp > XB_SPIN_CAP) { atomicAdd(&(bar)[XB_TMO], 1u); break; } } } } while (0)

struct XcdBarrier {
    unsigned* bar; unsigned x;
    volatile LAS unsigned* st;
};
__device__ __forceinline__ XcdBarrier xcd_barrier_post(unsigned* bar, volatile LAS unsigned* st) {
    XcdBarrier b; b.bar = bar; b.x = xb_xcc_id(); b.st = st;
    if (threadIdx.x == 0) (void)xb_add(&bar[XB_XCNT(b.x)], 1u);
    return b;
}
__device__ __forceinline__ void xcd_barrier_complete(unsigned* bar, unsigned x, unsigned& nloc, unsigned& nx) {
    const unsigned G = gridDim.x * gridDim.y * gridDim.z;
    unsigned sum, cnt, mine, sp = 0u;
    for (;;) {
        sum = 0u; cnt = 0u; mine = 0u;
#pragma unroll
        for (unsigned j = 0; j < 16; ++j) { const unsigned c = xb_ld(&bar[XB_XCNT(j)]); sum += c; cnt += (c > 0u) ? 1u : 0u; mine = (j == x) ? c : mine; }
        if (sum == G) break;
        __builtin_amdgcn_s_sleep(1);
        if ((++sp & 255u) == 0u) { if (xb_ld(&bar[XB_TMO])) break; if (sp > XB_SPIN_CAP) { atomicAdd(&bar[XB_TMO], 1u); break; } }
    }
    nloc = mine > 0u ? mine : 1u; nx = cnt > 0u ? cnt : 1u;
}
__device__ __forceinline__ void xcd_barrier(const XcdBarrier& b) {
    asm volatile("s_waitcnt vmcnt(0)" ::: "memory");
    __syncthreads();
    if (threadIdx.x == 0) {
        unsigned* bar = b.bar;
        __builtin_amdgcn_s_waitcnt(0);
        unsigned nloc = b.st[0], nx = b.st[1];
        if (nloc == 0u) { xcd_barrier_complete(bar, b.x, nloc, nx); b.st[0] = nloc; b.st[1] = nx; }
        const unsigned old = xb_add(&bar[XB_XSUB(b.x)], 1u);
        const unsigned gen = old / nloc;
        if (old + 1u == (gen + 1u) * nloc) {
            __builtin_amdgcn_fence(__ATOMIC_RELEASE, "agent");
            asm volatile("s_waitcnt vmcnt(0)" ::: "memory");
            const unsigned og = xb_add(&bar[XB_TOP], 1u);
            const unsigned tg = og / nx;
            if (og + 1u == (tg + 1u) * nx) xb_add(&bar[XB_TOPGEN], 1u);
            else XB_SPIN(xb_ld(&bar[XB_TOPGEN]) == tg, bar);
            __builtin_amdgcn_fence(__ATOMIC_ACQUIRE, "agent");
            xb_add(&bar[XB_XGEN(b.x)], 1u);
            asm volatile("s_waitcnt vmcnt(0)" ::: "memory");
        } else {
            XB_SPIN(xb_ld(&bar[XB_XGEN(b.x)]) == gen, bar);
            __builtin_amdgcn_fence(__ATOMIC_ACQUIRE, "agent");
            asm volatile("s_waitcnt vmcnt(0)" ::: "memory");
        }
    }
    __syncthreads();
}

namespace pg8 {
#define PG8_LAS __attribute__((address_space(3)))
constexpr int BM = 256, BK = 64, HALF = 128, HTB = HALF * BK * 2  , STAGE_BYTES = 8 * HTB, NXCD = 8, WGM = 8;
__host__ __device__ __forceinline__ int lds_byte(int r, int c) { const int st = (r >> 4) * 2 + (c >> 5), rr = r & 15, cc = c & 31, ob = rr * 64 + cc * 2; return st * 1024 + (ob ^ (((ob >> 9) & 1) << 5)); }
__host__ __device__ __forceinline__ void stage_rc(int b, int& R, int& C) { const int st = b / 1024, sb = b % 1024, swz = sb ^ (((sb >> 9) & 1) << 5); R = (st >> 1) * 16 + swz / 64; C = (st & 1) * 32 + (swz % 64) / 2; }
__host__ __device__ __forceinline__ int perm32(int rho) { const int n = rho >> 4, i = rho & 15; return 8 * (i >> 2) + 4 * n + (i & 3); }
struct Unit { int pm, pn; };
struct Gemm { const bf16_t* A; const bf16_t* Bt; int K, lda, ldb; const int* rowtok; };
struct StaticOrder {
    int nM, nN, nwg, G, c;
    __host__ __device__ void init(int M, int N, int G_, int c_) { nM = M / BM; nN = N / BM; nwg = nM * nN; G = G_; c = c_; }
    __host__ __device__ bool next(int i, Unit& u) const {
        const long L = (long)i * G + c; if (L >= nwg) return false;
        int wgid = (int)L; { const int q = nwg / NXCD, r = nwg % NXCD, xcd = wgid % NXCD, off = wgid / NXCD; wgid = (xcd < r ? xcd * (q + 1) : r * (q + 1) + (xcd - r) * q) + off; }
        const int nig = WGM * nN, gid = wgid / nig, fm = gid * WGM, gsz = (nM - fm) < WGM ? (nM - fm) : WGM;
        u.pm = fm + ((wgid % nig) % gsz); u.pn = (wgid % nig) / gsz; return true;
    }
    __device__ __forceinline__ void a_ready(const Unit&) const {}
    __device__ __forceinline__ void done(const Unit&) const {}
};
struct MoeOrder {
    const int* te; int ntile, ncol, G, c;
    __device__ bool next(int i, Unit& u) const {
        const long L = (long)i * G + c; if (L >= (long)ntile * ncol) return false;
        const int pm = (int)(L / ncol), j = (int)(L % ncol); u.pm = pm; u.pn = te[pm] * ncol + j; return true;
    }
    __device__ __forceinline__ void a_ready(const Unit&) const {}
    __device__ __forceinline__ void done(const Unit&) const {}
};
template <class Epi, class Sched, bool ALIGN_EPI = false, bool SP2 = false, bool GATHER = false>
__device__ __forceinline__ void gemm_phase(PG8_LAS unsigned char* lds, const Gemm g, const Sched& S, const Epi& E) {
    const int tid = ltid(), wid = __builtin_amdgcn_readfirstlane(tid >> 6), lane = tid & 63, wr = wid >> 2, wc = wid & 3, fr = lane & 15, fq = lane >> 4;
    int K_ = g.K; asm volatile("" : "+s"(K_));
    const int K = K_, nt = K / BK;
    unsigned voffA[2], voffB[2];
#pragma unroll
    for (int i = 0; i < 2; ++i) { int R, C; stage_rc(tid * 16 + i * 8192, R, C); const int Rb = Epi::PERM ? ((R & ~31) + perm32(R & 31)) : R;
        voffA[i] = (unsigned)(R * g.lda + C) * 2u; voffB[i] = (unsigned)(Rb * g.ldb + C) * 2u; }
    static_assert(!GATHER || SP2, "GATHER is implemented on the SP2 loop");
    int gR[2]; unsigned gC[2]; unsigned cG0[2] = {0u, 0u}, cG1[2] = {0u, 0u}, nG0[2] = {0u, 0u}, nG1[2] = {0u, 0u};
#pragma unroll
    for (int i = 0; i < 2; ++i) { int R, C; stage_rc(tid * 16 + i * 8192, R, C); gR[i] = R; gC[i] = (unsigned)C * 2u; }
#define PG8_GLOAD(G0, G1, u) do { if constexpr (GATHER) { _Pragma("unroll") for (int _i = 0; _i < 2; ++_i) { \
        G0[_i] = (unsigned)((const GAS int*)g.rowtok)[(u).pm * 256 + gR[_i]] * (unsigned)(g.lda * 2) + gC[_i]; \
        G1[_i] = (unsigned)((const GAS int*)g.rowtok)[(u).pm * 256 + 128 + gR[_i]] * (unsigned)(g.lda * 2) + gC[_i]; } } } while (0)
    const size_t kstep = (size_t)(BK * 2);
    const size_t hstepA = (size_t)HALF * g.lda * 2, hstepB = (size_t)HALF * g.ldb * 2;
    const size_t tstepA = 2 * hstepA, tstepB = 2 * hstepB;
    const unsigned ldsw = (unsigned)wid * 1024u;
    const int aoff = lds_byte(wr * 64 + fr, fq * 8), boff = lds_byte(wc * 32 + fr, fq * 8);
#define PG8_SA(b, h) (((b) * 2 + (h)) * HTB)
#define PG8_SB(b, h) ((4 + (b) * 2 + (h)) * HTB)
#define PG8_STAGE(bufoff, gbase, voff) do { _Pragma("unroll") for (int _i = 0; _i < 2; ++_i) \
        __builtin_amdgcn_global_load_lds((const unsigned*)((const char*)(gbase) + (voff)[_i]), (PG8_LAS unsigned*)(lds + (bufoff) + ldsw + _i * 8192), 16, 0, 0); } while (0)
#define PG8_LDA(dst, b, h) do { _Pragma("unroll") for (int m = 0; m < 4; ++m) _Pragma("unroll") for (int k = 0; k < 2; ++k) dst[m][k] = *(const PG8_LAS bf16x8*)(lds + PG8_SA(b, h) + aoff + m * 2048 + k * 1024); } while (0)
#define PG8_LDB(dst, b, h) do { _Pragma("unroll") for (int n = 0; n < 2; ++n) _Pragma("unroll") for (int k = 0; k < 2; ++k) dst[n][k] = *(const PG8_LAS bf16x8*)(lds + PG8_SB(b, h) + boff + n * 2048 + k * 1024); } while (0)
#define PG8_MMA(ai, bj, At, Bt) do { __builtin_amdgcn_s_setprio(1); _Pragma("unroll") for (int m = 0; m < 4; ++m) _Pragma("unroll") for (int n = 0; n < 2; ++n) _Pragma("unroll") for (int k = 0; k < 2; ++k) \
        acc[ai][bj][m][n] = __builtin_amdgcn_mfma_f32_16x16x32_bf16(Bt[n][k], At[m][k], acc[ai][bj][m][n], 0, 0, 0); __builtin_amdgcn_s_setprio(0); } while (0)
#define PG8_WAIT_V(n) asm volatile("s_waitcnt vmcnt(" #n ")" ::: "memory")
#define PG8_WAIT_L(n) asm volatile("s_waitcnt lgkmcnt(" #n ")" ::: "memory")
#define PG8_BAR __builtin_amdgcn_s_barrier()
#define PG8_SCHED __builtin_amdgcn_sched_barrier(0)
    Unit cur, nxt; int ui = 0;
    if (!S.next(0, cur)) return;
    f32x4 acc[2][2][4][2];
#pragma unroll
    for (int a = 0; a < 2; ++a)
#pragma unroll
        for (int b = 0; b < 2; ++b)
#pragma unroll
            for (int m = 0; m < 4; ++m)
#pragma unroll
                for (int n = 0; n < 2; ++n) acc[a][b][m][n] = (f32x4){0.f, 0.f, 0.f, 0.f};
    bf16x8 At[4][2], B0[2][2], B1[2][2];
    const char* cA = (const char*)g.A + (GATHER ? (size_t)0 : (size_t)cur.pm * tstepA); const char* cB = (const char*)g.Bt + (size_t)cur.pn * tstepB;
    S.a_ready(cur);
    PG8_GLOAD(cG0, cG1, cur);
#define PG8_STA(bufoff, P, half, SEL) do { if constexpr (GATHER) { PG8_STAGE(bufoff, P, (SEL) ? ((half) ? sG1 : sG0) : ((half) ? cG1 : cG0)); } else { PG8_STAGE(bufoff, (P) + ((half) ? hstepA : (size_t)0), voffA); } } while (0)
    unsigned sG0[2] = {0u, 0u}, sG1[2] = {0u, 0u};
    if constexpr (SP2) {
        PG8_STAGE(PG8_SB(0, 0), cB, voffB); PG8_STAGE(PG8_SB(0, 1), cB + hstepB, voffB); PG8_STA(PG8_SA(0, 0), cA, 0, false); PG8_STA(PG8_SA(0, 1), cA, 1, false);
        if (wr == 1) PG8_BAR;
        PG8_WAIT_V(2); PG8_BAR;
        PG8_STAGE(PG8_SB(1, 0), cB + kstep, voffB); PG8_STA(PG8_SA(1, 0), cA + kstep, 0, false); PG8_STAGE(PG8_SB(1, 1), cB + hstepB + kstep, voffB);
        PG8_WAIT_V(6); PG8_BAR;
    } else {
        PG8_STAGE(PG8_SB(0, 0), cB, voffB); PG8_STAGE(PG8_SA(0, 0), cA, voffA); PG8_STAGE(PG8_SB(0, 1), cB + hstepB, voffB); PG8_STAGE(PG8_SA(0, 1), cA + hstepA, voffA);
        if (wr == 1) PG8_BAR;
        PG8_WAIT_V(4); PG8_BAR;
        PG8_STAGE(PG8_SB(1, 0), cB + kstep, voffB); PG8_STAGE(PG8_SA(1, 0), cA + kstep, voffA); PG8_STAGE(PG8_SB(1, 1), cB + hstepB + kstep, voffB);
        PG8_WAIT_V(6); PG8_BAR;
    }
    for (;;) {
        const bool has_next = S.next(ui + 1, nxt);
        if (has_next) PG8_GLOAD(nG0, nG1, nxt);
        const char* nA = (has_next && !GATHER) ? (const char*)g.A + (size_t)nxt.pm * tstepA : cA; const char* nB = has_next ? (const char*)g.Bt + (size_t)nxt.pn * tstepB : cB;
#pragma clang loop unroll(disable)
        for (int t = 0; t < nt; t += 2) {
            const bool last = (t == nt - 2);
            const char* a1 = cA + (size_t)(t + 1) * kstep;
            const char* a2 = last ? nA : cA + (size_t)(t + 2) * kstep; const char* b2 = last ? nB : cB + (size_t)(t + 2) * kstep;
            const char* a3 = a2 + kstep; const char* b3 = b2 + kstep;
            if (last && has_next) S.a_ready(nxt);
            if constexpr (GATHER) { _Pragma("unroll") for (int _i = 0; _i < 2; ++_i) { sG0[_i] = cG0[_i]; sG1[_i] = cG1[_i]; } if (last && has_next) { _Pragma("unroll") for (int _i = 0; _i < 2; ++_i) { sG0[_i] = nG0[_i]; sG1[_i] = nG1[_i]; } } }
            if constexpr (SP2) {
            PG8_LDB(B0, 0, 0); PG8_LDB(B1, 0, 1); PG8_SCHED; PG8_LDA(At, 0, 0); PG8_STA(PG8_SA(1, 1), a1, 1, false);
            PG8_WAIT_V(8); PG8_WAIT_L(0); PG8_BAR; PG8_MMA(0, 0, At, B0); PG8_MMA(0, 1, At, B1); PG8_BAR; PG8_SCHED;
            PG8_LDA(At, 0, 1); PG8_STAGE(PG8_SB(0, 0), b2, voffB); PG8_STAGE(PG8_SB(0, 1), b2 + hstepB, voffB); PG8_STA(PG8_SA(0, 0), a2, 0, true);
            PG8_WAIT_V(8); PG8_WAIT_L(0); PG8_BAR; PG8_MMA(1, 0, At, B0); PG8_MMA(1, 1, At, B1); PG8_BAR; PG8_SCHED;
            PG8_LDB(B0, 1, 0); PG8_LDB(B1, 1, 1); PG8_SCHED; PG8_LDA(At, 1, 0); PG8_STA(PG8_SA(0, 1), a2, 1, true);
            PG8_WAIT_V(8); PG8_WAIT_L(0); PG8_BAR; PG8_MMA(0, 0, At, B0); PG8_MMA(0, 1, At, B1); PG8_BAR; PG8_SCHED;
            PG8_LDA(At, 1, 1); PG8_STAGE(PG8_SB(1, 0), b3, voffB); PG8_STAGE(PG8_SB(1, 1), b3 + hstepB, voffB); PG8_STA(PG8_SA(1, 0), a3, 0, true);
            PG8_WAIT_V(8); PG8_WAIT_L(0); PG8_BAR; PG8_MMA(1, 0, At, B0); PG8_MMA(1, 1, At, B1); PG8_BAR; PG8_SCHED;
            } else {
            PG8_LDB(B0, 0, 0); PG8_SCHED; PG8_LDA(At, 0, 0); PG8_STAGE(PG8_SA(1, 1), a1 + hstepA, voffA);
            PG8_WAIT_L(8); PG8_BAR; PG8_WAIT_L(0); PG8_MMA(0, 0, At, B0); PG8_BAR; PG8_SCHED;
            PG8_LDB(B1, 0, 1); PG8_STAGE(PG8_SB(0, 0), b2, voffB);
            PG8_BAR; PG8_WAIT_L(0); PG8_MMA(0, 1, At, B1); PG8_BAR;
            PG8_LDA(At, 0, 1); PG8_STAGE(PG8_SA(0, 0), a2, voffA);
            PG8_BAR; PG8_WAIT_L(0); PG8_MMA(1, 0, At, B0); PG8_BAR; PG8_SCHED;
            PG8_STAGE(PG8_SB(0, 1), b2 + hstepB, voffB);
            PG8_WAIT_V(6); PG8_BAR; PG8_MMA(1, 1, At, B1); PG8_BAR;
            PG8_LDB(B0, 1, 0); PG8_SCHED; PG8_LDA(At, 1, 0); PG8_STAGE(PG8_SA(0, 1), a2 + hstepA, voffA);
            PG8_WAIT_L(8); PG8_BAR; PG8_WAIT_L(0); PG8_MMA(0, 0, At, B0); PG8_BAR; PG8_SCHED;
            PG8_LDB(B1, 1, 1); PG8_STAGE(PG8_SB(1, 0), b3, voffB);
            PG8_BAR; PG8_WAIT_L(0); PG8_MMA(0, 1, At, B1); PG8_BAR;
            PG8_LDA(At, 1, 1); PG8_STAGE(PG8_SA(1, 0), a3, voffA);
            PG8_BAR; PG8_WAIT_L(0); PG8_MMA(1, 0, At, B0); PG8_BAR; PG8_SCHED;
            PG8_STAGE(PG8_SB(1, 1), b3 + hstepB, voffB);
            PG8_WAIT_V(6); PG8_BAR; PG8_MMA(1, 1, At, B1); PG8_BAR;
            }
        }
        if constexpr (ALIGN_EPI) { if (wr == 0) PG8_BAR; }
        if constexpr (!Epi::AFTER_DRAIN) { E(acc, cur, wr, wc, fr, fq); S.done(cur); }
        if (!has_next) break;
#pragma unroll
        for (int a = 0; a < 2; ++a)
#pragma unroll
            for (int b = 0; b < 2; ++b)
#pragma unroll
                for (int m = 0; m < 4; ++m)
#pragma unroll
                    for (int n = 0; n < 2; ++n) acc[a][b][m][n] = (f32x4){0.f, 0.f, 0.f, 0.f};
        cur = nxt; cA = nA; cB = nB; ++ui;
        if constexpr (GATHER) { _Pragma("unroll") for (int _i = 0; _i < 2; ++_i) { cG0[_i] = nG0[_i]; cG1[_i] = nG1[_i]; } }
        if constexpr (ALIGN_EPI) { if (wr == 1) PG8_BAR; }
    }
    PG8_WAIT_V(0);
    if constexpr (!ALIGN_EPI) { if (wr == 0) PG8_BAR; }
    PG8_BAR;
    if constexpr (Epi::AFTER_DRAIN) { E.fused(acc, cur, wr, wc, fr, fq, lds, wid, lane); S.done(cur); }
#undef PG8_SA
#undef PG8_SB
#undef PG8_STAGE
#undef PG8_STA
#undef PG8_GLOAD
#undef PG8_LDA
#undef PG8_LDB
#undef PG8_MMA
#undef PG8_WAIT_V
#undef PG8_WAIT_L
#undef PG8_BAR
#undef PG8_SCHED
}
}

namespace epi {
using pg8::Unit;
__device__ __forceinline__ u32x4 pack8(f32x4 a, f32x4 b) { u32x4 w; w.x = cvtpk(a[0], a[1]); w.y = cvtpk(a[2], a[3]); w.z = cvtpk(b[0], b[1]); w.w = cvtpk(b[2], b[3]); return w; }
__device__ __forceinline__ u32x2 pack4(f32x4 a) { u32x2 w; w.x = cvtpk(a[0], a[1]); w.y = cvtpk(a[2], a[3]); return w; }

struct Store {
    static constexpr bool PERM = true, AFTER_DRAIN = false;
    bf16_t* O; int ldc; const float* rowscale;
    __device__ __forceinline__ void operator()(const f32x4 (&acc)[2][2][4][2], const Unit& u, int wr, int wc, int fr, int fq) const {
        int pm_ = u.pm, pn_ = u.pn, lrow_ = wr * 64 + fr, lcol_ = wc * 32 + 8 * fq;
        asm volatile("" : "+s"(pm_), "+s"(pn_), "+v"(lrow_), "+v"(lcol_));
#pragma unroll
        for (int ai = 0; ai < 2; ++ai)
#pragma unroll
            for (int m = 0; m < 4; ++m) {
                const int row = pm_ * 256 + ai * 128 + m * 16 + lrow_;
                const float sc = rowscale ? ((const GAS float*)rowscale)[row] : 1.f;
                GAS bf16_t* rp = (GAS bf16_t*)O + (size_t)row * ldc + pn_ * 256 + lcol_;
#pragma unroll
                for (int bj = 0; bj < 2; ++bj) *(GAS u32x4*)(rp + bj * 128) = pack8(acc[ai][bj][m][0] * sc, acc[ai][bj][m][1] * sc);
            }
    }
};
__device__ __forceinline__ unsigned pk4_fp8(f32x4 v) { int w = 0; w = __builtin_amdgcn_cvt_pk_fp8_f32(v[0], v[1], w, false); w = __builtin_amdgcn_cvt_pk_fp8_f32(v[2], v[3], w, true); return (unsigned)w; }
struct QRope {
    static constexpr bool PERM = true, AFTER_DRAIN = false;
    unsigned char* Q; const float* rsq; const float* rope;
    __device__ __forceinline__ void operator()(const f32x4 (&acc)[2][2][4][2], const Unit& u, int wr, int wc, int fr, int fq) const {
        int pm_ = u.pm, pn_ = u.pn, lrow_ = wr * 64 + fr, lcol_ = wc * 32 + 8 * fq;
        asm volatile("" : "+s"(pm_), "+s"(pn_), "+v"(lrow_), "+v"(lcol_));
#pragma unroll
        for (int ai = 0; ai < 2; ++ai)
#pragma unroll
            for (int m = 0; m < 4; ++m) {
                const int row = pm_ * 256 + ai * 128 + m * 16 + lrow_;
                const float sc = ((const GAS float*)rsq)[row] * (C2 * 16.f);
                GAS unsigned char* rp = (GAS unsigned char*)Q + (size_t)row * QW;
#pragma unroll
                for (int bj = 0; bj < 2; ++bj) {
                    const int g32 = 8 * pn_ + 4 * bj + (lcol_ >> 5), head = g32 / 3, part = g32 - 3 * head, fq8 = lcol_ & 31, fq4 = fq8 >> 1;
                    const f32x4 v0 = acc[ai][bj][m][0] * sc, v1 = acc[ai][bj][m][1] * sc;
                    if (part < 2) { u32x2 w; w.x = pk4_fp8(v0); w.y = pk4_fp8(v1); *(GAS u32x2*)(rp + 32 * g32 + fq8) = w; }
                    else {
                        const f32x4 cs = *(const GAS f32x4*)((const GAS float*)rope + (size_t)row * 32 + fq4), sn = *(const GAS f32x4*)((const GAS float*)rope + (size_t)row * 32 + 16 + fq4);
                        const f32x4 o1 = v0 * cs - v1 * sn, o2 = v0 * sn + v1 * cs;
                        *(GAS unsigned*)(rp + head * 96 + 64 + fq4) = pk4_fp8(o1);
                        *(GAS unsigned*)(rp + head * 96 + 80 + fq4) = pk4_fp8(o2);
                    }
                }
            }
    }
};
struct StoreKV {
    static constexpr bool PERM = true, AFTER_DRAIN = false;
    bf16_t* VB; unsigned char* K8; const float* rowscale;
    __device__ __forceinline__ void operator()(const f32x4 (&acc)[2][2][4][2], const Unit& u, int wr, int wc, int fr, int fq) const {
        int pm_ = u.pm, pn_ = u.pn, lrow_ = wr * 64 + fr, lcol_ = wc * 32 + 8 * fq;
        asm volatile("" : "+s"(pm_), "+s"(pn_), "+v"(lrow_), "+v"(lcol_));
#pragma unroll
        for (int ai = 0; ai < 2; ++ai)
#pragma unroll
            for (int m = 0; m < 4; ++m) {
                const int row = pm_ * 256 + ai * 128 + m * 16 + lrow_;
                const float sc = ((const GAS float*)rowscale)[row];
#pragma unroll
                for (int bj = 0; bj < 2; ++bj) { const f32x4 v0 = acc[ai][bj][m][0] * sc, v1 = acc[ai][bj][m][1] * sc; const int head = pn_ * 2 + bj;
                    if (lcol_ < 64) { u32x2 w; w.x = pk4_fp8(v0); w.y = pk4_fp8(v1); *(GAS u32x2*)((GAS unsigned char*)K8 + ((size_t)row * 8 + head) * 64 + lcol_) = w; }
                    else *(GAS u32x4*)((GAS bf16_t*)VB + (size_t)row * 512 + head * 64 + (lcol_ - 64)) = pack8(v0, v1); }
            }
    }
};
struct Resid {
    static constexpr bool PERM = true, AFTER_DRAIN = false;
    const float* R; float* X;
    __device__ __forceinline__ void operator()(const f32x4 (&acc)[2][2][4][2], const Unit& u, int wr, int wc, int fr, int fq) const {
        int pm_ = u.pm, pn_ = u.pn, lrow_ = wr * 64 + fr, lcol_ = wc * 32 + 8 * fq;
        asm volatile("" : "+s"(pm_), "+s"(pn_), "+v"(lrow_), "+v"(lcol_));
#pragma unroll
        for (int ai = 0; ai < 2; ++ai)
#pragma unroll
            for (int m = 0; m < 4; ++m) {
                const int row = pm_ * 256 + ai * 128 + m * 16 + lrow_;
                const size_t p0 = (size_t)row * DM + pn_ * 256 + lcol_;
#pragma unroll
                for (int bj = 0; bj < 2; ++bj) {
                    const size_t p = p0 + bj * 128;
                    const f32x4 r0 = *(const GAS f32x4*)((const GAS float*)R + p), r1 = *(const GAS f32x4*)((const GAS float*)R + p + 4);
                    *(GAS f32x4*)((GAS float*)X + p) = r0 + acc[ai][bj][m][0];
                    *(GAS f32x4*)((GAS float*)X + p + 4) = r1 + acc[ai][bj][m][1];
                }
            }
    }
};
struct GateUp {
    static constexpr bool PERM = true, AFTER_DRAIN = false;
    bf16_t* HE;
    __device__ __forceinline__ void operator()(const f32x4 (&acc)[2][2][4][2], const Unit& u, int wr, int wc, int fr, int fq) const {
        int pm_ = u.pm, pn_ = u.pn, lrow_ = wr * 64 + fr, lcol_ = wc * 32 + 8 * fq;
        asm volatile("" : "+s"(pm_), "+s"(pn_), "+v"(lrow_), "+v"(lcol_));
        const int j = pn_ & 1;
#pragma unroll
        for (int ai = 0; ai < 2; ++ai)
#pragma unroll
            for (int m = 0; m < 4; ++m) {
                const int row = pm_ * 256 + ai * 128 + m * 16 + lrow_;
                GAS bf16_t* rp = (GAS bf16_t*)HE + (size_t)row * DEXP + j * 128 + (lcol_ >> 1);
#pragma unroll
                for (int bj = 0; bj < 2; ++bj) {
                    const f32x4 g = acc[ai][bj][m][0], up = acc[ai][bj][m][1]; f32x4 h;
#pragma unroll
                    for (int i = 0; i < 4; ++i) h[i] = g[i] * __builtin_amdgcn_rcpf(1.f + __expf(-g[i])) * up[i];
                    *(GAS u32x2*)(rp + bj * 64) = pack4(h);
                }
            }
    }
};
struct Down {
    static constexpr bool PERM = true, AFTER_DRAIN = false;
    bf16_t* Y; const int* src; const float* wgt;
    __device__ __forceinline__ void operator()(const f32x4 (&acc)[2][2][4][2], const Unit& u, int wr, int wc, int fr, int fq) const {
        int pm_ = u.pm, pn_ = u.pn, lrow_ = wr * 64 + fr, lcol_ = wc * 32 + 8 * fq;
        asm volatile("" : "+s"(pm_), "+s"(pn_), "+v"(lrow_), "+v"(lcol_));
        const int j = pn_ & 3;
#pragma unroll
        for (int ai = 0; ai < 2; ++ai)
#pragma unroll
            for (int m = 0; m < 4; ++m) {
                const int row = pm_ * 256 + ai * 128 + m * 16 + lrow_;
                const int s = ((const GAS int*)src)[row];
                if (s >= 0) {
                    const float w = ((const GAS float*)wgt)[row];
                    GAS bf16_t* rp = (GAS bf16_t*)Y + ((size_t)(s & 1) * T + (s >> 1)) * DM + j * 256 + lcol_;
#pragma unroll
                    for (int bj = 0; bj < 2; ++bj) *(GAS u32x4*)(rp + bj * 128) = pack8(acc[ai][bj][m][0] * w, acc[ai][bj][m][1] * w);
                }
            }
    }
};
}

namespace att {
constexpr int KROW = 112, VROW = 192, KT = 64 * KROW, VT = 64 * VROW, BUF = KT + VT;
typedef int v8i32_t __attribute__((ext_vector_type(8)));
typedef int v4i32_t __attribute__((ext_vector_type(4)));
#define MFMA8(a, b, c) __builtin_amdgcn_mfma_scale_f32_32x32x64_f8f6f4(a, b, c, 0, 0, 0, 0x7F7F7F7F, 0, 0x7B7B7B7B)
constexpr int LDS_WS = 2 * BUF, LDS_BYTES = LDS_WS + 8 * 256;
constexpr float THR_L2 = 8.f * 1.4426950408889634f;
__device__ __forceinline__ void partialSM(f32x16& p0, f32x16& p1, float& m_reg, float& mn, float& alpha) {
    float pmax = p0[0];
#pragma unroll
    for (int r = 1; r < 16; ++r) pmax = fmaxf(pmax, p0[r]);
#pragma unroll
    for (int r = 0; r < 16; ++r) pmax = fmaxf(pmax, p1[r]);
    { auto rr = __builtin_amdgcn_permlane32_swap(__float_as_uint(pmax), __float_as_uint(pmax), false, false);
      pmax = fmaxf(__uint_as_float(rr[0]), __uint_as_float(rr[1])); }
    if (__builtin_expect(__all(pmax - m_reg <= THR_L2), 1)) { mn = m_reg; alpha = 1.f; }
    else { mn = fmaxf(m_reg, pmax); alpha = __builtin_amdgcn_exp2f(m_reg - mn); m_reg = mn; }
#pragma unroll
    for (int r = 0; r < 16; ++r) p0[r] = p0[r] - mn;
#pragma unroll
    for (int r = 0; r < 16; ++r) p1[r] = p1[r] - mn;
#pragma unroll
    for (int r = 0; r < 16; ++r) p0[r] = __builtin_amdgcn_exp2f(p0[r]);
}
__device__ __forceinline__ void finishSM(f32x16& p0, f32x16& p1, float alpha, float& l_reg, bf16x8& pa0, bf16x8& pa1, bf16x8& pa2, bf16x8& pa3) {
#pragma unroll
    for (int r = 0; r < 16; ++r) p1[r] = __builtin_amdgcn_exp2f(p1[r]);
    float ps = 0;
#pragma unroll
    for (int r = 0; r < 16; ++r) ps += p0[r];
#pragma unroll
    for (int r = 0; r < 16; ++r) ps += p1[r];
    { auto rr = __builtin_amdgcn_permlane32_swap(__float_as_uint(ps), __float_as_uint(ps), false, false);
      ps = __uint_as_float(rr[0]) + __uint_as_float(rr[1]); }
    l_reg = l_reg * alpha + ps;
    PK4(p0, 0, pa0); PK4(p0, 8, pa1); PK4(p1, 0, pa2); PK4(p1, 8, pa3);
}
__device__ __forceinline__ void qkt(f32x16& p0, f32x16& p1, const LAS unsigned char* Ks, const v8i32_t* q8, int r32, int hi) {
    const v8i32_t a0 = *(const LAS v8i32_t*)(Ks + r32 * KROW + 32 * hi), a1 = *(const LAS v8i32_t*)(Ks + (32 + r32) * KROW + 32 * hi);
    const v8i32_t c0 = *(const LAS v8i32_t*)(Ks + r32 * KROW + 64), c1 = *(const LAS v8i32_t*)(Ks + (32 + r32) * KROW + 64);
    p0 = MFMA8(a0, q8[0], (f32x16){}); p1 = MFMA8(a1, q8[0], (f32x16){});
    p0 = MFMA8(c0, q8[1], p0); p1 = MFMA8(c1, q8[1], p1);
}
__device__ __forceinline__ void load_q8(v8i32_t* q8, const unsigned char* Qrow, int hi) {
    const v4i32_t x0 = *(const GAS v4i32_t*)((const GAS unsigned char*)Qrow + 32 * hi), x1 = *(const GAS v4i32_t*)((const GAS unsigned char*)Qrow + 32 * hi + 16);
    v4i32_t y0 = *(const GAS v4i32_t*)((const GAS unsigned char*)Qrow + 64), y1 = *(const GAS v4i32_t*)((const GAS unsigned char*)Qrow + 80);
    if (hi) { y0 = (v4i32_t){0, 0, 0, 0}; y1 = (v4i32_t){0, 0, 0, 0}; }
    q8[0] = __builtin_shufflevector(x0, x1, 0, 1, 2, 3, 4, 5, 6, 7); q8[1] = __builtin_shufflevector(y0, y1, 0, 1, 2, 3, 4, 5, 6, 7);
}
__device__ __forceinline__ void pv(f32x16* o, const LAS unsigned char* vb, bf16x8 pa0, bf16x8 pa1, bf16x8 pa2, bf16x8 pa3) {
#pragma unroll
    for (int d0 = 0; d0 < 2; ++d0) {
        const bf16x8 v0 = tr_frag(vb + 0 * 16 * VROW + d0 * 64, VROW), v1 = tr_frag(vb + 1 * 16 * VROW + d0 * 64, VROW);
        const bf16x8 v2 = tr_frag(vb + 2 * 16 * VROW + d0 * 64, VROW), v3 = tr_frag(vb + 3 * 16 * VROW + d0 * 64, VROW);
        o[d0] = __builtin_amdgcn_mfma_f32_32x32x16_bf16(pa0, v0, o[d0], 0, 0, 0);
        o[d0] = __builtin_amdgcn_mfma_f32_32x32x16_bf16(pa1, v1, o[d0], 0, 0, 0);
        o[d0] = __builtin_amdgcn_mfma_f32_32x32x16_bf16(pa2, v2, o[d0], 0, 0, 0);
        o[d0] = __builtin_amdgcn_mfma_f32_32x32x16_bf16(pa3, v3, o[d0], 0, 0, 0);
    }
}
struct Stage8 {
    const GAS unsigned char* vsrc; const GAS unsigned char* ksrc; unsigned kstride; int vdst, kdst; bool has_k;
    __device__ __forceinline__ void init(const bf16_t* VBg, const unsigned char* K8g, const unsigned char* KR8g, int b, int h, int tid) {
        const int sr = tid >> 3, sc = (tid & 7) * 8;
        vsrc = (const GAS unsigned char*)((const GAS bf16_t*)VBg + (size_t)(b * SEQ + sr) * 512 + h * 64 + sc); vdst = KT + sr * VROW + sc * 2;
        has_k = tid < 384;
        if (tid < 256) { const int key = tid >> 2, c = tid & 3; ksrc = (const GAS unsigned char*)K8g + ((size_t)(b * SEQ + key) * 8 + h) * 64 + c * 16; kstride = 64 * 512; kdst = key * KROW + c * 16; }
        else { const int t2 = (tid - 256) & 127, key = t2 >> 1, c = t2 & 1; ksrc = (const GAS unsigned char*)KR8g + (size_t)(b * SEQ + key) * 32 + c * 16; kstride = 64 * 32; kdst = key * KROW + 64 + c * 16; }
    }
};
struct StageRegs { u32x4 v, k; };
#define S8_LOAD(R, S, tile) do { (R).v = *(const GAS u32x4*)((S).vsrc + (size_t)(tile) * (64 * 512 * 2)); (R).k = *(const GAS u32x4*)((S).ksrc + (size_t)(tile) * (S).kstride); } while (0)
#define S8_WRITE(lds_, bo, R, S) do { *(LAS u32x4*)((lds_) + (bo) + (S).vdst) = (R).v; if ((S).has_k) *(LAS u32x4*)((lds_) + (bo) + (S).kdst) = (R).k; } while (0)

__device__ __forceinline__ void attn_unit(const unsigned char* Q8g, const bf16_t* KVg, const unsigned char* K8g, const unsigned char* KR8g, bf16_t* CATg, int b, int h, int qb, LAS unsigned char* lds) {
    const int tid = ltid(), wid = tid >> 6, lane = tid & 63, r32 = lane & 31, hi = lane >> 5;
    LAS float* wsf = (LAS float*)(lds + LDS_WS) + wid * 64; LAS float* li_l = wsf; LAS float* al_l = wsf + 32;
    float m_reg = -1e30f, l_reg = 0; f32x16 o[2] = {}; v8i32_t q8[2];
    load_q8(q8, Q8g + (size_t)(b * SEQ + qb * 256 + wid * 32 + r32) * QW + h * QKD, hi);
    Stage8 sg; sg.init(KVg, K8g, KR8g, b, h, tid);
    const LAS unsigned char* vb0 = lds + KT + tr_lane_off(lane, VROW);
    StageRegs st0, st1;
#define SWAIT() asm volatile("s_waitcnt vmcnt(2)" ::: "memory")
#define RESC(a) do { if (__any((a) < 1.f)) { if (hi == 0) al_l[r32] = (a); LDS_WAIT(); \
    _Pragma("unroll") for (int d = 0; d < 2; ++d) _Pragma("unroll") for (int r = 0; r < 16; ++r) o[d][r] *= al_l[crow(r, hi)]; } } while (0)
    f32x16 pA0, pA1, pB0, pB1; float mnA, mnB, alA, alB; bf16x8 pa0, pa1, pa2, pa3; constexpr int NT = SEQ / 64;
    __syncthreads();
    S8_LOAD(st0, sg, 0); VM_WAIT(); S8_WRITE(lds, 0, st0, sg); __syncthreads();
    qkt(pA0, pA1, lds, q8, r32, hi); partialSM(pA0, pA1, m_reg, mnA, alA);
    S8_LOAD(st1, sg, 1); S8_LOAD(st0, sg, 2);
    SWAIT(); S8_WRITE(lds, BUF, st1, sg); __syncthreads();
    for (int j = 1; j + 1 < NT; j += 2) {
        SBAR(); qkt(pB0, pB1, lds + BUF, q8, r32, hi);
        finishSM(pA0, pA1, alA, l_reg, pa0, pa1, pa2, pa3); SBAR();
        S8_LOAD(st1, sg, j + 2); SBAR();
        pv(o, vb0, pa0, pa1, pa2, pa3); partialSM(pB0, pB1, m_reg, mnB, alB);
        __syncthreads(); SWAIT(); S8_WRITE(lds, 0, st0, sg);
        RESC(alB); __syncthreads();
        SBAR(); qkt(pA0, pA1, lds, q8, r32, hi);
        finishSM(pB0, pB1, alB, l_reg, pa0, pa1, pa2, pa3); SBAR();
        if (j + 3 < NT) S8_LOAD(st0, sg, j + 3); SBAR();
        pv(o, vb0 + BUF, pa0, pa1, pa2, pa3); partialSM(pA0, pA1, m_reg, mnA, alA);
        __syncthreads(); SWAIT(); S8_WRITE(lds, BUF, st1, sg);
        RESC(alA); __syncthreads();
    }
    SBAR(); qkt(pB0, pB1, lds + BUF, q8, r32, hi);
    finishSM(pA0, pA1, alA, l_reg, pa0, pa1, pa2, pa3); SBAR();
    pv(o, vb0, pa0, pa1, pa2, pa3); partialSM(pB0, pB1, m_reg, mnB, alB);
    __syncthreads(); RESC(alB);
    finishSM(pB0, pB1, alB, l_reg, pa0, pa1, pa2, pa3); SBAR();
    pv(o, vb0 + BUF, pa0, pa1, pa2, pa3);
    if (hi == 0) li_l[r32] = l_reg; LDS_WAIT();
    GAS bf16_t* Ow = (GAS bf16_t*)CATg + (size_t)(b * SEQ + qb * 256 + wid * 32) * DM + 512 + h * 64 + r32;
#pragma unroll
    for (int r = 0; r < 16; ++r) { const int orow = crow(r, hi); const float rl = __builtin_amdgcn_rcpf(li_l[orow]);
#pragma unroll
        for (int d0 = 0; d0 < 2; ++d0) Ow[(size_t)orow * DM + d0 * 32] = (bf16_t)f2bf(o[d0][r] * rl); }
#undef SWAIT
#undef RESC
}
__device__ __forceinline__ int tr_lane_off2(int lane, int stride) { const int i = lane & 15; return ((lane >> 5) * 4 + (i >> 2)) * stride + (((lane >> 4) & 1) * 16 + (i & 3) * 4) * 2; }
__device__ __forceinline__ bf16x8 tr_frag2(const LAS unsigned char* p, int stride) { const s16x4 a = vtr(p), b = vtr(p + 8 * stride); return (bf16x8){a[0], a[1], a[2], a[3], b[0], b[1], b[2], b[3]}; }
constexpr int LDS_WS3 = 3 * BUF;
typedef float f32x2_t __attribute__((ext_vector_type(2)));
typedef __bf16 bf16x2_t __attribute__((ext_vector_type(2)));
__device__ __forceinline__ unsigned cvtpk_s(float lo, float hi) { f32x2_t v = {lo, hi}; bf16x2_t r = __builtin_convertvector(v, bf16x2_t); return __builtin_bit_cast(unsigned, r); }
#ifndef ATT_SGB
#define ATT_SGB 1
#endif
#define SGB(mask, n) do { if (ATT_SGB) __builtin_amdgcn_sched_group_barrier(mask, n, 0); } while (0)
__device__ __forceinline__ int vt_pos(int k) { return 32 * ((k >> 2) & 1) + (k & 3) + 4 * ((k & 31) >> 3) + 16 * (k >> 5); }
constexpr int VTROW = 80, VT8 = 64 * VTROW, BUF8 = KT + VT8;
constexpr int LDS_WSF = 8 * BUF8;
#define MFMA8PV(a, b, c) __builtin_amdgcn_mfma_scale_f32_32x32x64_f8f6f4(a, b, c, 1  , 0  , 0, 0x7F7F7F7F, 0, 0x7F7F7F7F)
__device__ __forceinline__ void vt_phase(LAS unsigned char* lds, const bf16_t* VBg, unsigned char* V8T) {
    const int tid = ltid(), wid = tid >> 6, lane = tid & 63;
    LAS unsigned char* blk = lds + wid * 4096;
    const int gw = lbid() * 8 + wid, NGW = gridDim.x * 8, pos = vt_pos(lane);
    for (int u = gw; u < BATCH * NH * (SEQ / 64); u += NGW) {
        const int tile = u & 255, bh = u >> 8, b = bh >> 3, h = bh & 7;
        const GAS bf16_t* src = (const GAS bf16_t*)VBg + (size_t)(b * SEQ + tile * 64 + lane) * 512 + h * 64;
#pragma unroll
        for (int c8 = 0; c8 < 8; ++c8) { const u32x4 w = *(const GAS u32x4*)(src + c8 * 8);
            const int w0 = __builtin_amdgcn_cvt_pk_fp8_f32(bflo(w.x), bfhi(w.x), 0, false), w1 = __builtin_amdgcn_cvt_pk_fp8_f32(bflo(w.y), bfhi(w.y), 0, false);
            const int w2 = __builtin_amdgcn_cvt_pk_fp8_f32(bflo(w.z), bfhi(w.z), 0, false), w3 = __builtin_amdgcn_cvt_pk_fp8_f32(bflo(w.w), bfhi(w.w), 0, false);
            LAS unsigned char* p = blk + (c8 * 8) * 64 + pos;
            p[0] = (unsigned char)w0; p[64] = (unsigned char)(w0 >> 8); p[128] = (unsigned char)w1; p[192] = (unsigned char)(w1 >> 8);
            p[256] = (unsigned char)w2; p[320] = (unsigned char)(w2 >> 8); p[384] = (unsigned char)w3; p[448] = (unsigned char)(w3 >> 8); }
        LDS_WAIT(); asm volatile("" ::: "memory");
        GAS unsigned char* dst = (GAS unsigned char*)V8T + (size_t)u * 4096;
#pragma unroll
        for (int k = 0; k < 4; ++k) *(GAS u32x4*)(dst + (lane + 64 * k) * 16) = *(const LAS u32x4*)(blk + (lane + 64 * k) * 16);
        LDS_WAIT(); asm volatile("" ::: "memory");
    }
}
struct StageF {
    const GAS unsigned char* asrc; unsigned astride; int adst; const GAS unsigned char* rsrc; int rdst; bool has_r;
    __device__ __forceinline__ void init(const unsigned char* K8g, const unsigned char* KR8g, const unsigned char* V8Tg, int b, int h, int tid) {
        if (tid < 256) { const int key = tid >> 2, c = tid & 3; asrc = (const GAS unsigned char*)K8g + ((size_t)(b * SEQ + key) * 8 + h) * 64 + c * 16; astride = 64 * 512; adst = key * KROW + c * 16; }
        else { const int c = tid - 256, col = c >> 2, part = c & 3; asrc = (const GAS unsigned char*)V8Tg + (size_t)((b * NH + h) * (SEQ / 64)) * 4096 + c * 16; astride = 4096; adst = KT + col * VTROW + part * 16; }
        has_r = tid < 128; { const int t2 = tid & 127, key = t2 >> 1, c = t2 & 1; rsrc = (const GAS unsigned char*)KR8g + (size_t)(b * SEQ + key) * 32 + c * 16; rdst = key * KROW + 64 + c * 16; }
    }
};
struct StageFRegs { u32x4 a, r; };
#define SF_LOAD(R, S, tile) do { (R).a = *(const GAS u32x4*)((S).asrc + (size_t)(tile) * (S).astride); (R).r = *(const GAS u32x4*)((S).rsrc + (size_t)(tile) * 2048); } while (0)
#define SF_WRITE(lds_, bo, R, S) do { *(LAS u32x4*)((lds_) + (bo) + (S).adst) = (R).a; *(LAS u32x4*)((lds_) + (bo) + (S).rdst) = (R).r; } while (0)
__device__ __forceinline__ int pk4_bf8(float a, float b, float c, float d) { int w = __builtin_bit_cast(int, a);
    w = __builtin_amdgcn_cvt_pk_bf8_f32(a, b, w, false); w = __builtin_amdgcn_cvt_pk_bf8_f32(c, d, w, true); return w; }
template <int PM> __device__ __forceinline__ bool attn_unit_fast(const unsigned char* Q8g, const unsigned char* K8g, const unsigned char* KR8g, const unsigned char* V8Tg, bf16_t* CATg, int b, int h, int qb, LAS unsigned char* lds) {
    const int tid = ltid(), wid = tid >> 6, lane = tid & 63, r32 = lane & 31, hi = lane >> 5;
    f32x16 o0 = {}, o1 = {}, o2 = {}; v8i32_t q8[2];
    int onesw = 0x38383838, zw = 0; asm volatile("" : "+v"(onesw), "+v"(zw));
    const v8i32_t ones = {onesw, onesw, onesw, onesw, onesw, onesw, onesw, onesw};
    load_q8(q8, Q8g + (size_t)(b * SEQ + qb * 256 + wid * 32 + r32) * QW + h * QKD, hi);
    StageF sg; sg.init(K8g, KR8g, V8Tg, b, h, tid);
    const LAS unsigned char* kl = lds + r32 * KROW;
    const LAS unsigned char* vl = lds + KT + r32 * VTROW + 32 * hi;
    StageFRegs st0;
    f32x16 pA0, pA1, pB0, pB1; constexpr int NT = SEQ / 64;
    if (hi) { q8[1] = (v8i32_t){0, 0, 0, 0, 0xD0, 0, 0, 0}; }
    __syncthreads();
    if (tid == 0) *(LAS unsigned*)(lds + LDS_WSF + 2048) = 0u;
    *(LAS u32x4*)(lds + (tid >> 6) * BUF8 + (tid & 63) * KROW + 96) = (u32x4){(unsigned)zw + 0x50u, (unsigned)zw, (unsigned)zw, (unsigned)zw};
    SF_LOAD(st0, sg, 0); VM_WAIT(); SF_WRITE(lds, 0, st0, sg); SF_LOAD(st0, sg, 1); VM_WAIT(); SF_WRITE(lds, BUF8, st0, sg); SF_LOAD(st0, sg, 2); VM_WAIT(); SF_WRITE(lds, 2 * BUF8, st0, sg);
    SF_LOAD(st0, sg, 3); VM_WAIT(); SF_WRITE(lds, 3 * BUF8, st0, sg); SF_LOAD(st0, sg, 4);
    __syncthreads();
    {
        const v8i32_t a0 = *(const LAS v8i32_t*)(kl + 32 * hi), a1 = *(const LAS v8i32_t*)(kl + 32 * KROW + 32 * hi), c0 = *(const LAS v8i32_t*)(kl + 64 + 16 * hi), c1 = *(const LAS v8i32_t*)(kl + 32 * KROW + 64 + 16 * hi);
        pA0 = MFMA8(a0, q8[0], (f32x16){}); pA1 = MFMA8(a1, q8[0], (f32x16){}); pA0 = MFMA8(c0, q8[1], pA0); pA1 = MFMA8(c1, q8[1], pA1);
    }
    v8i32_t nka0 = *(const LAS v8i32_t*)(kl + BUF8 + 32 * hi), nkb0 = *(const LAS v8i32_t*)(kl + BUF8 + 32 * KROW + 32 * hi);
    v8i32_t pap = {0, 0, 0, 0, 0, 0, 0, 0};
#define ATT_ITER(X0, X1, Y0, Y1, ST, HAS_NEXT, DO_WRITE, DO_LOAD, JLOAD, BARRIER) do { \
        const LAS unsigned char* kp = kl + o_nxt; const LAS unsigned char* vp = vl + o_prv; \
        const v8i32_t ka0 = nka0, kb0 = nkb0; \
        const v8i32_t va = *(const LAS v8i32_t*)(vp), vb = *(const LAS v8i32_t*)(vp + 32 * VTROW); \
        const v8i32_t ka1 = *(const LAS v8i32_t*)(kp + 64 + 16 * hi), kb1 = *(const LAS v8i32_t*)(kp + 32 * KROW + 64 + 16 * hi); \
        SBAR(); \
        if (HAS_NEXT) { Y0 = MFMA8(ka0, q8[0], (f32x16){}); Y1 = MFMA8(kb0, q8[0], (f32x16){}); } \
        o0 = MFMA8PV(pap, va, o0); o1 = MFMA8PV(pap, vb, o1); \
        if (HAS_NEXT) { Y0 = MFMA8(ka1, q8[1], Y0); Y1 = MFMA8(kb1, q8[1], Y1); } \
        o2 = MFMA8PV(pap, ones, o2); \
        _Pragma("unroll") for (int r = 0; r < 16; ++r) { X0[r] = __builtin_amdgcn_exp2f(X0[r]); X1[r] = __builtin_amdgcn_exp2f(X1[r]); } \
        v8i32_t pan; \
        pan[0] = pk4_bf8(X0[0], X0[1], X0[2], X0[3]); pan[1] = pk4_bf8(X0[4], X0[5], X0[6], X0[7]); pan[2] = pk4_bf8(X0[8], X0[9], X0[10], X0[11]); pan[3] = pk4_bf8(X0[12], X0[13], X0[14], X0[15]); \
        pan[4] = pk4_bf8(X1[0], X1[1], X1[2], X1[3]); pan[5] = pk4_bf8(X1[4], X1[5], X1[6], X1[7]); pan[6] = pk4_bf8(X1[8], X1[9], X1[10], X1[11]); pan[7] = pk4_bf8(X1[12], X1[13], X1[14], X1[15]); \
        SGB(0x8, 1); SGB(0x400, 8); SGB(0x8, 1); SGB(0x400, 8); SGB(0x8, 1); SGB(0x400, 8); SGB(0x8, 1); SGB(0x400, 8); \
        SGB(0x8, 1); SGB(0x2, 8); SGB(0x8, 1); SGB(0x2, 8); SGB(0x8, 1); SGB(0x2, 8); \
        SBAR(); \
        pap = pan; \
        if (DO_WRITE) { SF_WRITE(lds, o_wr, ST, sg); SF_LOAD(ST, sg, JLOAD); }     \
        { const LAS unsigned char* kn = kl + o_nn; nka0 = *(const LAS v8i32_t*)(kn + 32 * hi); nkb0 = *(const LAS v8i32_t*)(kn + 32 * KROW + 32 * hi); }     \
        if ((BARRIER) && !(PM & 4)) __syncthreads(); } while (0)
    int c8 = 0;
#define OFF8(k) (((c8 + (k)) & 7) * BUF8)
#define CLAMP(t) ((t) < NT ? (t) : NT - 1)
    {
        { const int o_prv = OFF8(0), o_nxt = OFF8(1), o_wr = OFF8(4), o_nn = OFF8(2); ATT_ITER(pA0, pA1, pB0, pB1, st0, true, true, true, 5, false); }
        { const int o_prv = OFF8(0), o_nxt = OFF8(2), o_wr = OFF8(5), o_nn = OFF8(3); ATT_ITER(pB0, pB1, pA0, pA1, st0, true, true, true, 6, true); }
        c8 = 2;
    }
    for (int j = 2; j < NT - 2; j += 2) {
        { const int o_prv = OFF8(7), o_nxt = OFF8(1), o_wr = OFF8(4), o_nn = OFF8(2); ATT_ITER(pA0, pA1, pB0, pB1, st0, true, true, true, CLAMP(j + 5), false); }
        { const int o_prv = OFF8(0), o_nxt = OFF8(2), o_wr = OFF8(5), o_nn = OFF8(3); ATT_ITER(pB0, pB1, pA0, pA1, st0, true, true, true, CLAMP(j + 6), true); }
        c8 = (c8 + 2) & 7;
    }
    {
        { const int o_prv = OFF8(7), o_nxt = OFF8(1), o_wr = 0, o_nn = OFF8(1); (void)o_wr; ATT_ITER(pA0, pA1, pB0, pB1, st0, true, false, false, 0, false); }
        { const int o_prv = OFF8(0), o_nxt = OFF8(2), o_wr = 0, o_nn = OFF8(1); (void)o_wr; ATT_ITER(pB0, pB1, pA0, pA1, st0, false, false, false, 0, true); }
    }
#undef CLAMP
    {
        const LAS unsigned char* vp = vl + ((NT - 1) & 7) * BUF8;
        const v8i32_t va = *(const LAS v8i32_t*)(vp), vb = *(const LAS v8i32_t*)(vp + 32 * VTROW);
        o0 = MFMA8PV(pap, va, o0); o1 = MFMA8PV(pap, vb, o1); o2 = MFMA8PV(pap, ones, o2);
    }
#undef OFF8
    float fin = 0.f; bool lbad = false;
#pragma unroll
    for (int r = 0; r < 16; ++r) { fin += fabsf(o0[r]) + fabsf(o1[r]); lbad |= !(o2[r] > 0.f) || !(o2[r] < 57000.f); }
    const bool bad = !(fin < 3.0e38f) || lbad;
    GAS bf16_t* Ow = (GAS bf16_t*)CATg + (size_t)(b * SEQ + qb * 256 + wid * 32) * DM + 512 + h * 64 + r32;
#pragma unroll
    for (int r = 0; r < 16; ++r) { const int orow = crow(r, hi); const float rl = __builtin_amdgcn_rcpf(o2[r]);
        Ow[(size_t)orow * DM] = (bf16_t)f2bf(o0[r] * rl); Ow[(size_t)orow * DM + 32] = (bf16_t)f2bf(o1[r] * rl); }
#undef ATT_ITER
    LAS unsigned* flag = (LAS unsigned*)(lds + LDS_WSF + 2048);
    if (bad) *flag = 1u;
    __syncthreads();
    const bool redo = (*flag != 0u);
    __syncthreads();
    return redo;
}
#ifndef ATT_FORCE_EXACT
#define ATT_FORCE_EXACT 0
#endif
template <int PM> __device__ __forceinline__ void attn_phase(const unsigned char* Qg, const bf16_t* KVg, const unsigned char* K8g, const unsigned char* KRg, const unsigned char* V8Tg, bf16_t* CATg, LAS unsigned char* lds) {
    const int G = gridDim.x, bid = lbid();
    constexpr int NU = BATCH * NH * (SEQ / 256);
    if (G == 256) {
        const int xcd = bid & 7, j = bid >> 3;
        for (int i = 0; i < 4; ++i) { const int bh = 2 * xcd + (i >> 1), qb = j + 32 * (i & 1); if ((attn_unit_fast<PM>(Qg, K8g, KRg, V8Tg, CATg, bh >> 3, bh & 7, qb, lds) || ATT_FORCE_EXACT) && PM == 0) attn_unit(Qg, KVg, K8g, KRg, CATg, bh >> 3, bh & 7, qb, lds); }
    } else {
        for (int u = bid; u < NU; u += G) { const int bh = u >> 6, qb = u & 63; if ((attn_unit_fast<PM>(Qg, K8g, KRg, V8Tg, CATg, bh >> 3, bh & 7, qb, lds) || ATT_FORCE_EXACT) && PM == 0) attn_unit(Qg, KVg, K8g, KRg, CATg, bh >> 3, bh & 7, qb, lds); }
    }
}
}

namespace gla {
constexpr int L_WA = 0, L_BA = 16384, L_A = 17408, L_LA = 25600, L_T0 = 58368;
constexpr int QROW = 272, L_QD = L_T0, L_KI = L_T0 + 64 * QROW;
constexpr int KEROW = 320, L_KE = L_T0;
constexpr int VROW = 576, L_V = 93184, L_NG = L_V + 64 * VROW, L_END = L_NG + 256;
constexpr int OSROW = 260;
static_assert(L_KI + 64 * QROW <= L_V && L_LA + 64 * OSROW * 4 <= L_V && L_END <= 131072, "gla lds map");

__device__ __forceinline__ void load_consts(LAS unsigned char* lds, const float* waf, const float* baf, const float* wab, const float* bab, const float* ng) {
    const int tid = ltid();
    LAS float* wa = (LAS float*)(lds + L_WA); LAS float* ba = (LAS float*)(lds + L_BA);
    for (int i = tid; i < 2048; i += 512) { wa[i] = ((const GAS float*)waf)[i]; wa[2048 + i] = ((const GAS float*)wab)[i]; }
    if (tid < 128) { ba[tid] = ((const GAS float*)baf)[tid]; ba[128 + tid] = ((const GAS float*)bab)[tid]; }
    if (tid < 64) ((LAS float*)(lds + L_NG))[tid] = ((const GAS float*)ng)[tid];
}
constexpr int L_TOT = 131072 + 1024;
__device__ __forceinline__ void compute_la(LAS unsigned char* lds, int dir) {
    const int tid = ltid(), c = tid & 127, seg = tid >> 7;
    const LAS float* wa = (const LAS float*)(lds + L_WA) + dir * 2048; const LAS float* a = (const LAS float*)(lds + L_A) + dir * 16 + seg * 16 * 32;
    LAS float* la = (LAS float*)(lds + L_LA) + seg * 16 * 128 + c; LAS float* tot = (LAS float*)(lds + L_TOT);
    float w[16], v[16];
#pragma unroll
    for (int r = 0; r < 16; ++r) w[r] = wa[r * 128 + c];
    const float bias = ((const LAS float*)(lds + L_BA))[dir * 128 + c];
#pragma unroll
    for (int k = 0; k < 16; ++k) { float s = bias;
#pragma unroll
        for (int q = 0; q < 4; ++q) { const f32x4 av = *(const LAS f32x4*)(a + k * 32 + 4 * q);
            s = fmaf(av[0], w[4 * q], s); s = fmaf(av[1], w[4 * q + 1], s); s = fmaf(av[2], w[4 * q + 2], s); s = fmaf(av[3], w[4 * q + 3], s); }
        const float e = __builtin_amdgcn_exp2f(fabsf(s) * -1.4426950408889634f);
        v[k] = (fminf(s, 0.f) - 0.6931471805599453f * __builtin_amdgcn_logf(1.f + e)) * (1.f / 16.f); }
    if (dir == 0) {
#pragma unroll
        for (int k = 1; k < 16; ++k) v[k] += v[k - 1];
        tot[seg * 128 + c] = v[15];
    } else {
#pragma unroll
        for (int k = 14; k >= 0; --k) v[k] += v[k + 1];
        tot[seg * 128 + c] = v[0];
    }
    __syncthreads();
    float off = 0.f;
#pragma unroll
    for (int q = 0; q < 4; ++q) { const float tq = tot[q * 128 + c]; off += ((dir == 0) ? (q < seg) : (q > seg)) ? tq : 0.f; }
#pragma unroll
    for (int k = 0; k < 16; ++k) la[k * 128] = v[k] + off;
}
__device__ __forceinline__ void g1_unit(LAS unsigned char* lds, const bf16_t* P, float* S, float* DEC, int cidx, const float* ROPE, float* RSQ, float* RSKV, unsigned char* KR) {
    const int tid = ltid(), wid = tid >> 6, lane = tid & 63, r32 = lane & 31, hi = lane >> 5;
    const int b = cidx >> 8, n = cidx & 255, token0 = cidx * 64;
    __syncthreads();
    u32x4 vv[4], aw = {}, kw[2];
#pragma unroll
    for (int k = 0; k < 4; ++k) { const int id = tid + 512 * k, row = id >> 5, c = id & 31;
        vv[k] = *(const GAS u32x4*)((const GAS bf16_t*)P + (size_t)(token0 + row) * PW + PC_GV + c * 8); }
    if (tid < 256) aw = *(const GAS u32x4*)((const GAS bf16_t*)P + (size_t)(token0 + (tid >> 2)) * PW + PC_AF + (tid & 3) * 8);
#pragma unroll
    for (int k = 0; k < 2; ++k) { const int id = tid + 512 * k, row = id >> 4, c8 = (id & 15) * 8;
        kw[k] = *(const GAS u32x4*)((const GAS bf16_t*)P + (size_t)(token0 + row) * PW + PC_GK + c8); }
    const int token = token0 + (tid >> 3), sub = tid & 7;
    const GAS bf16_t* pr = (const GAS bf16_t*)P + (size_t)token * PW;
    u32x4 cq[4], ck[2];
#pragma unroll
    for (int k = 0; k < 4; ++k) cq[k] = *(const GAS u32x4*)(pr + PC_CQ + sub * 32 + k * 8);
#pragma unroll
    for (int k = 0; k < 2; ++k) ck[k] = *(const GAS u32x4*)(pr + PC_CKV + sub * 16 + k * 8);
    const unsigned w1 = *(const GAS unsigned*)(pr + PC_KR + 2 * sub), w2 = *(const GAS unsigned*)(pr + PC_KR + 16 + 2 * sub);
    const GAS float* rp = (const GAS float*)ROPE + (size_t)token * 32 + 2 * sub;
    const float c0 = rp[0], c1 = rp[1], s0 = rp[16], s1 = rp[17];
#pragma unroll
    for (int k = 0; k < 4; ++k) { const int id = tid + 512 * k, row = id >> 5, c = id & 31; *(LAS u32x4*)(lds + L_V + row * VROW + c * 16) = vv[k]; }
    if (tid < 256) { LAS float* a = (LAS float*)(lds + L_A) + (tid >> 2) * 32 + (tid & 3) * 8;
        a[0] = bflo(aw.x); a[1] = bfhi(aw.x); a[2] = bflo(aw.y); a[3] = bfhi(aw.y); a[4] = bflo(aw.z); a[5] = bfhi(aw.z); a[6] = bflo(aw.w); a[7] = bfhi(aw.w); }
    {   float sq = 0.f, skv = 0.f;
#pragma unroll
        for (int k = 0; k < 4; ++k) { const u32x4 w = cq[k];
            const float a0 = bflo(w.x), a1 = bfhi(w.x), a2 = bflo(w.y), a3 = bfhi(w.y), a4 = bflo(w.z), a5 = bfhi(w.z), a6 = bflo(w.w), a7 = bfhi(w.w);
            sq += (a0 * a0 + a1 * a1) + (a2 * a2 + a3 * a3) + (a4 * a4 + a5 * a5) + (a6 * a6 + a7 * a7); }
#pragma unroll
        for (int k = 0; k < 2; ++k) { const u32x4 w = ck[k];
            const float a0 = bflo(w.x), a1 = bfhi(w.x), a2 = bflo(w.y), a3 = bfhi(w.y), a4 = bflo(w.z), a5 = bfhi(w.z), a6 = bflo(w.w), a7 = bfhi(w.w);
            skv += (a0 * a0 + a1 * a1) + (a2 * a2 + a3 * a3) + (a4 * a4 + a5 * a5) + (a6 * a6 + a7 * a7); }
#pragma unroll
        for (int o = 1; o < 8; o <<= 1) { sq += shflx(sq, o); skv += shflx(skv, o); }
        if (sub == 0) { ((GAS float*)RSQ)[token] = rsqrtf(sq * (1.f / 256.f) + EPS); ((GAS float*)RSKV)[token] = rsqrtf(skv * (1.f / 128.f) + EPS); }
        const float x10 = bflo(w1), x11 = bfhi(w1), x20 = bflo(w2), x21 = bfhi(w2);
        *(GAS unsigned short*)((GAS unsigned char*)KR + (size_t)token * 32 + 2 * sub) = (unsigned short)__builtin_amdgcn_cvt_pk_fp8_f32(x10 * c0 - x20 * s0, x11 * c1 - x21 * s1, 0, false);
        *(GAS unsigned short*)((GAS unsigned char*)KR + (size_t)token * 32 + 16 + 2 * sub) = (unsigned short)__builtin_amdgcn_cvt_pk_fp8_f32(x10 * s0 + x20 * c0, x11 * s1 + x21 * c1, 0, false);
    }
    __syncthreads();
    for (int dir = 0; dir < 2; ++dir) {
        compute_la(lds, dir); __syncthreads();
        const LAS float* la = (const LAS float*)(lds + L_LA); const LAS float* bl = la + (dir ? 0 : 63) * 128;
#pragma unroll
        for (int k = 0; k < 2; ++k) { const int id = tid + 512 * k, row = id >> 4, c8 = (id & 15) * 8;
            const u32x4 w = kw[k];
            float kv[8] = {bflo(w.x), bfhi(w.x), bflo(w.y), bfhi(w.y), bflo(w.z), bfhi(w.z), bflo(w.w), bfhi(w.w)};
#pragma unroll
            for (int j = 0; j < 8; ++j) kv[j] *= __expf(bl[c8 + j] - la[row * 128 + c8 + j]);
            u32x4 o; o.x = pk2(kv[0], kv[1]); o.y = pk2(kv[2], kv[3]); o.z = pk2(kv[4], kv[5]); o.w = pk2(kv[6], kv[7]);
            *(LAS u32x4*)(lds + L_KE + row * KEROW + c8 * 2) = o; }
        const size_t sbase = (size_t)((dir * 2 + b) * NCHUNK + n);
        if (tid < 128) ((GAS float*)DEC)[sbase * 128 + tid] = __expf(bl[tid]);
        __syncthreads();
        { const int h = wid >> 1, vb = wid & 1;
          const LAS unsigned char* ab = lds + L_KE + tr_lane_off(lane, KEROW) + h * 64;
          const LAS unsigned char* bb = lds + L_V + tr_lane_off(lane, VROW) + (h * 64 + vb * 32) * 2;
          f32x16 acc = {};
#pragma unroll
          for (int ks = 0; ks < 4; ++ks) { const bf16x8 af = tr_frag(ab + ks * 16 * KEROW, KEROW), bf = tr_frag(bb + ks * 16 * VROW, VROW);
              acc = __builtin_amdgcn_mfma_f32_32x32x16_bf16(af, bf, acc, 0, 0, 0); }
          GAS float* sp = (GAS float*)S + (sbase * 4 + h) * 2048 + vb * 32 + r32;
#pragma unroll
          for (int r = 0; r < 16; ++r) sp[crow(r, hi) * 64] = acc[r]; }
    }
}
constexpr int L_AB = 32768;
__device__ __forceinline__ void g2_scan(LAS unsigned char* lds, float* S, const float* DEC) {
    const int tid = ltid(), el = tid & 127, seg = tid >> 7;
    LAS float* ab = (LAS float*)(lds + L_AB);
    for (int g0 = lbid() * 128; g0 < 4 * 8192; g0 += gridDim.x * 128) {
        const int g = g0 + el, e = g & 8191, db = g >> 13, dir = db >> 1;
        const int n0 = dir ? (NCHUNK - 1 - seg * 64) : seg * 64;
        GAS float* sp = (GAS float*)S + ((size_t)db * NCHUNK + n0) * 8192 + e; const GAS float* dp = (const GAS float*)DEC + ((size_t)db * NCHUNK + n0) * 128 + (e >> 6);
        const long ss = dir ? -8192 : 8192, ds = dir ? -128 : 128;
        float kv[64], dc[64];
        {   const GAS float* p = sp; const GAS float* q = dp;
#pragma unroll
            for (int i = 0; i < 64; ++i) { kv[i] = *p; dc[i] = *q; p += ss; q += ds; asm volatile("" : "+v"(p), "+v"(q)); } }
        float state = 0.f, cp = 1.f;
#pragma unroll
        for (int i = 0; i < 64; ++i) { const float k = kv[i], d = dc[i]; kv[i] = state; dc[i] = cp; state = fmaf(d, state, k); cp *= d; }
        __syncthreads();
        ab[(seg * 128 + el) * 2] = cp; ab[(seg * 128 + el) * 2 + 1] = state;
        __syncthreads();
        float sin = 0.f;
#pragma unroll
        for (int q = 0; q < 3; ++q) { const float aq = ab[(q * 128 + el) * 2], bq = ab[(q * 128 + el) * 2 + 1]; sin = (q < seg) ? fmaf(aq, sin, bq) : sin; }
        {   GAS float* p = sp;
#pragma unroll
            for (int i = 0; i < 64; ++i) { *p = fmaf(dc[i], sin, kv[i]); p += ss; asm volatile("" : "+v"(p)); } }
    }
}
__device__ __forceinline__ void g3_dir(LAS unsigned char* lds, const int dir, const u32x4 (&qw)[2], const u32x4 (&kw)[2], const float (&sv)[32], f32x16 (&o)[2]) {
    const int tid = ltid(), wid = tid >> 6, lane = tid & 63, r32 = lane & 31, hi = lane >> 5;
    const int h = wid >> 1, ib = wid & 1, iq = ib * 32 + r32;
    compute_la(lds, dir); __syncthreads();
    const LAS float* la = (const LAS float*)(lds + L_LA);
#pragma unroll
    for (int k = 0; k < 2; ++k) { const int id = tid + 512 * k, row = id >> 4, c8 = (id & 15) * 8;
        const u32x4 wq = qw[k], wk = kw[k];
        float qv[8] = {bflo(wq.x), bfhi(wq.x), bflo(wq.y), bfhi(wq.y), bflo(wq.z), bfhi(wq.z), bflo(wq.w), bfhi(wq.w)};
        float kv[8] = {bflo(wk.x), bfhi(wk.x), bflo(wk.y), bfhi(wk.y), bflo(wk.z), bfhi(wk.z), bflo(wk.w), bfhi(wk.w)};
#pragma unroll
        for (int j = 0; j < 8; ++j) { const float bb = la[row * 128 + c8 + j]; qv[j] *= 0.17677669529663687f * __expf(bb); kv[j] *= __expf(-bb); }
        u32x4 oq, ok; oq.x = pk2(qv[0], qv[1]); oq.y = pk2(qv[2], qv[3]); oq.z = pk2(qv[4], qv[5]); oq.w = pk2(qv[6], qv[7]);
        ok.x = pk2(kv[0], kv[1]); ok.y = pk2(kv[2], kv[3]); ok.z = pk2(kv[4], kv[5]); ok.w = pk2(kv[6], kv[7]);
        *(LAS u32x4*)(lds + L_QD + row * QROW + c8 * 2) = oq; *(LAS u32x4*)(lds + L_KI + row * QROW + c8 * 2) = ok; }
    __syncthreads();
    f32x16 p0 = {}, p1 = {}; bf16x8 qf[2];
#pragma unroll
    for (int ks = 0; ks < 2; ++ks) { const int cb = (h * 32 + ks * 16 + hi * 8) * 2;
        const bf16x8 a0 = *(const LAS bf16x8*)(lds + L_KI + r32 * QROW + cb), a1 = *(const LAS bf16x8*)(lds + L_KI + (32 + r32) * QROW + cb);
        qf[ks] = *(const LAS bf16x8*)(lds + L_QD + iq * QROW + cb);
        p0 = __builtin_amdgcn_mfma_f32_32x32x16_bf16(a0, qf[ks], p0, 0, 0, 0);
        p1 = __builtin_amdgcn_mfma_f32_32x32x16_bf16(a1, qf[ks], p1, 0, 0, 0); }
#pragma unroll
    for (int r = 0; r < 16; ++r) { const int j0 = crow(r, hi), j1 = 32 + j0;
        const bool k0 = dir ? (j0 > iq) : (j0 <= iq), k1 = dir ? (j1 > iq) : (j1 <= iq);
        p0[r] = k0 ? p0[r] : 0.f; p1[r] = k1 ? p1[r] : 0.f; }
    bf16x8 pa0, pa1, pa2, pa3;
    PK4(p0, 0, pa0); PK4(p0, 8, pa1); PK4(p1, 0, pa2); PK4(p1, 8, pa3);
    const LAS unsigned char* vbp = lds + L_V + tr_lane_off(lane, VROW) + h * 128;
#pragma unroll
    for (int vb = 0; vb < 2; ++vb) {
        const bf16x8 v0 = tr_frag(vbp + 0 * 16 * VROW + vb * 64, VROW), v1 = tr_frag(vbp + 1 * 16 * VROW + vb * 64, VROW);
        const bf16x8 v2 = tr_frag(vbp + 2 * 16 * VROW + vb * 64, VROW), v3 = tr_frag(vbp + 3 * 16 * VROW + vb * 64, VROW);
        o[vb] = __builtin_amdgcn_mfma_f32_32x32x16_bf16(pa0, v0, o[vb], 0, 0, 0);
        o[vb] = __builtin_amdgcn_mfma_f32_32x32x16_bf16(pa1, v1, o[vb], 0, 0, 0);
        o[vb] = __builtin_amdgcn_mfma_f32_32x32x16_bf16(pa2, v2, o[vb], 0, 0, 0);
        o[vb] = __builtin_amdgcn_mfma_f32_32x32x16_bf16(pa3, v3, o[vb], 0, 0, 0);
#pragma unroll
        for (int ks = 0; ks < 2; ++ks) { u32x4 w;
            w.x = pk2(sv[vb * 16 + ks * 8 + 0], sv[vb * 16 + ks * 8 + 1]); w.y = pk2(sv[vb * 16 + ks * 8 + 2], sv[vb * 16 + ks * 8 + 3]);
            w.z = pk2(sv[vb * 16 + ks * 8 + 4], sv[vb * 16 + ks * 8 + 5]); w.w = pk2(sv[vb * 16 + ks * 8 + 6], sv[vb * 16 + ks * 8 + 7]);
            o[vb] = __builtin_amdgcn_mfma_f32_32x32x16_bf16(qf[ks], __builtin_bit_cast(bf16x8, w), o[vb], 0, 0, 0); }
    }
    __syncthreads();
}
__device__ __forceinline__ void g3_unit(LAS unsigned char* lds, const bf16_t* P, const float* S, bf16_t* CAT, int cidx) {
    const int tid = ltid(), wid = tid >> 6, lane = tid & 63, r32 = lane & 31, hi = lane >> 5;
    const int b = cidx >> 8, n = cidx & 255, token0 = cidx * 64;
    const int h = wid >> 1, ib = wid & 1;
    __syncthreads();
    u32x4 vv[4], aw = {}, qw[2], kw[2], gw[4]; float sv0[32], sv1[32];
#pragma unroll
    for (int k = 0; k < 4; ++k) { const int id = tid + 512 * k, row = id >> 5, c = id & 31;
        vv[k] = *(const GAS u32x4*)((const GAS bf16_t*)P + (size_t)(token0 + row) * PW + PC_GV + c * 8); }
    if (tid < 256) aw = *(const GAS u32x4*)((const GAS bf16_t*)P + (size_t)(token0 + (tid >> 2)) * PW + PC_AF + (tid & 3) * 8);
#pragma unroll
    for (int k = 0; k < 2; ++k) { const int id = tid + 512 * k, row = id >> 4, c8 = (id & 15) * 8;
        qw[k] = *(const GAS u32x4*)((const GAS bf16_t*)P + (size_t)(token0 + row) * PW + PC_GQ + c8);
        kw[k] = *(const GAS u32x4*)((const GAS bf16_t*)P + (size_t)(token0 + row) * PW + PC_GK + c8); }
    {   const GAS float* sg = (const GAS float*)S + ((size_t)((0 * 2 + b) * NCHUNK + n) * 4 + h) * 2048 + r32;
#pragma unroll
        for (int vb = 0; vb < 2; ++vb)
#pragma unroll
            for (int ks = 0; ks < 2; ++ks)
#pragma unroll
                for (int j = 0; j < 8; ++j) sv0[vb * 16 + ks * 8 + j] = sg[(ks * 16 + hi * 8 + j) * 64 + vb * 32]; }
    const int et = tid >> 3, ehh = (tid >> 1) & 3, ehalf = tid & 1;
    {   const GAS bf16_t* gp = (const GAS bf16_t*)P + (size_t)(token0 + et) * PW + PC_GG + ehh * 64 + ehalf * 32;
#pragma unroll
        for (int k = 0; k < 4; ++k) gw[k] = *(const GAS u32x4*)(gp + 8 * k); }
    {   const GAS float* sg = (const GAS float*)S + ((size_t)((1 * 2 + b) * NCHUNK + n) * 4 + h) * 2048 + r32;
#pragma unroll
        for (int vb = 0; vb < 2; ++vb)
#pragma unroll
            for (int ks = 0; ks < 2; ++ks)
#pragma unroll
                for (int j = 0; j < 8; ++j) sv1[vb * 16 + ks * 8 + j] = sg[(ks * 16 + hi * 8 + j) * 64 + vb * 32]; }
#pragma unroll
    for (int k = 0; k < 4; ++k) { const int id = tid + 512 * k, row = id >> 5, c = id & 31; *(LAS u32x4*)(lds + L_V + row * VROW + c * 16) = vv[k]; }
    if (tid < 256) { LAS float* a = (LAS float*)(lds + L_A) + (tid >> 2) * 32 + (tid & 3) * 8;
        a[0] = bflo(aw.x); a[1] = bfhi(aw.x); a[2] = bflo(aw.y); a[3] = bfhi(aw.y); a[4] = bflo(aw.z); a[5] = bfhi(aw.z); a[6] = bflo(aw.w); a[7] = bfhi(aw.w); }
    __syncthreads();
    f32x16 o[2] = {};
    g3_dir(lds, 0, qw, kw, sv0, o);
    g3_dir(lds, 1, qw, kw, sv1, o);
    {
        LAS float* os = (LAS float*)(lds + L_LA);
#pragma unroll
        for (int vb = 0; vb < 2; ++vb)
#pragma unroll
            for (int r = 0; r < 16; ++r) os[(ib * 32 + crow(r, hi)) * OSROW + h * 64 + vb * 32 + r32] = o[vb][r];
    }
    __syncthreads();
    {
        const LAS float* os = (const LAS float*)(lds + L_LA) + et * OSROW + ehh * 64 + ehalf * 32; const LAS float* ng = (const LAS float*)(lds + L_NG) + ehalf * 32;
        float v[32]; float ss = 0.f;
#pragma unroll
        for (int j = 0; j < 8; ++j) { const f32x4 x = *(const LAS f32x4*)(os + 4 * j); v[4 * j] = x[0]; v[4 * j + 1] = x[1]; v[4 * j + 2] = x[2]; v[4 * j + 3] = x[3]; ss += (x[0] * x[0] + x[1] * x[1]) + (x[2] * x[2] + x[3] * x[3]); }
        ss += shflx(ss, 1);
        const float rstd = rsqrtf(ss * (1.f / 64.f) + EPS);
        GAS bf16_t* op = (GAS bf16_t*)CAT + (size_t)(token0 + et) * DM + ehh * 64 + ehalf * 32;
#pragma unroll
        for (int k = 0; k < 4; ++k) { const u32x4 w = gw[k];
            const float gv[8] = {bflo(w.x), bfhi(w.x), bflo(w.y), bfhi(w.y), bflo(w.z), bfhi(w.z), bflo(w.w), bfhi(w.w)}; float ov[8];
#pragma unroll
            for (int j = 0; j < 8; ++j) { const float g = gv[j]; ov[j] = v[8 * k + j] * rstd * ng[8 * k + j] * (g * __builtin_amdgcn_rcpf(1.f + __expf(-g))); }
            u32x4 ow; ow.x = pk2(ov[0], ov[1]); ow.y = pk2(ov[2], ov[3]); ow.z = pk2(ov[4], ov[5]); ow.w = pk2(ov[6], ov[7]);
            *(GAS u32x4*)(op + 8 * k) = ow; }
    }
}
}

namespace fnet {
constexpr int ZROW = 320, L_Z = 0, LDS_BYTES = 128 * ZROW;
template <int STEP>
__device__ __forceinline__ void phase(LAS unsigned char* lds, const bf16_t* src, bf16_t* dst, const bf16_t* DFTW) {
    const int tid = ltid(), wid = tid >> 6, lane = tid & 63, r32 = lane & 31, hi = lane >> 5;
    const int kb = wid >> 1, db = wid & 1;
    bf16x8 wr[8], wi[8], nwi[8];
#pragma unroll
    for (int ks = 0; ks < 8; ++ks) { const size_t off = (size_t)(32 * kb + r32) * 128 + ks * 16 + hi * 8;
        wr[ks] = *(const GAS bf16x8*)((const GAS bf16_t*)DFTW + off);
        if (STEP == 1) wi[ks] = *(const GAS bf16x8*)((const GAS bf16_t*)DFTW + 16384 + off);
        nwi[ks] = *(const GAS bf16x8*)((const GAS bf16_t*)DFTW + 32768 + off); }
    const LAS unsigned char* zb = lds + L_Z + tr_lane_off(lane, ZROW) + db * 64;
    u32x4 zt[4];
#define FN_LOAD(u_) do { const int ub_ = (u_) >> 9, ui_ = ((u_) >> 2) & 127, ug_ = (u_) & 3; _Pragma("unroll") for (int k = 0; k < 4; ++k) { const int id = tid + 512 * k, row = id >> 4, c = id & 15; \
        const GAS bf16_t* sp = (STEP == 1) ? (const GAS bf16_t*)src + (size_t)(ub_ * SEQ + 128 * row + ui_) * PW + PC_Z + ug_ * 128 + c * 8 \
                                           : (const GAS bf16_t*)src + (size_t)(ub_ * SEQ + ui_ * 128 + row) * 512 + ug_ * 128 + c * 8; \
        zt[k] = *(const GAS u32x4*)sp; } } while (0)
    if (lbid() < 1024) FN_LOAD(lbid());
    for (int u = lbid(); u < 1024; u += gridDim.x) {
        const int b = u >> 9, idx = (u >> 2) & 127, g = u & 3;
        __syncthreads();
#pragma unroll
        for (int k = 0; k < 4; ++k) { const int id = tid + 512 * k, row = id >> 4, c = id & 15; *(LAS u32x4*)(lds + L_Z + row * ZROW + c * 16) = zt[k]; }
        __syncthreads();
        if (u + (int)gridDim.x < 1024) FN_LOAD(u + (int)gridDim.x);
        f32x16 cr = {}, ci = {};
#pragma unroll
        for (int ks = 0; ks < 8; ++ks) {
            const bf16x8 br = tr_frag(zb + ks * 16 * ZROW, ZROW), bi = tr_frag(zb + ks * 16 * ZROW + 128, ZROW);
            cr = __builtin_amdgcn_mfma_f32_32x32x16_bf16(wr[ks], br, cr, 0, 0, 0);
            cr = __builtin_amdgcn_mfma_f32_32x32x16_bf16(nwi[ks], bi, cr, 0, 0, 0);
            if (STEP == 1) { ci = __builtin_amdgcn_mfma_f32_32x32x16_bf16(wi[ks], br, ci, 0, 0, 0);
                             ci = __builtin_amdgcn_mfma_f32_32x32x16_bf16(wr[ks], bi, ci, 0, 0, 0); }
        }
        if (STEP == 1) {
#pragma unroll
            for (int r = 0; r < 16; ++r) { const int k1 = 32 * kb + crow(r, hi); const int mm = (idx * k1) & 16383;
                const float rev = (float)mm * (1.f / 16384.f); const float cs = __builtin_amdgcn_cosf(rev), sn = -__builtin_amdgcn_sinf(rev);
                const float yr = cr[r] * cs - ci[r] * sn, yi = cr[r] * sn + ci[r] * cs;
                GAS bf16_t* op = (GAS bf16_t*)dst + (size_t)(b * SEQ + k1 * 128 + idx) * 512 + g * 128 + db * 32 + r32;
                op[0] = (bf16_t)f2bf(yr); op[64] = (bf16_t)f2bf(yi); }
        } else {
#pragma unroll
            for (int r = 0; r < 16; ++r) { const int k2 = 32 * kb + crow(r, hi);
                ((GAS bf16_t*)dst)[(size_t)(b * SEQ + idx + 128 * k2) * DM + 256 + g * 64 + db * 32 + r32] = (bf16_t)f2bf(cr[r]); }
        }
    }
#undef FN_LOAD
}
}

namespace nrm {
template <bool ADD_Y, bool FINAL>
__device__ __forceinline__ void phase(const float* xin, const bf16_t* Y, float* xout, const float* g, bf16_t* XN, float* OUT) {
    const int lane = ltid() & 63, gw = lbid() * 8 + (ltid() >> 6), NGW = gridDim.x * 8;
    f32x4 gv[2][2];
#pragma unroll
    for (int k = 0; k < 2; ++k) { gv[k][0] = *(const GAS f32x4*)((const GAS float*)g + 8 * lane + 512 * k); gv[k][1] = *(const GAS f32x4*)((const GAS float*)g + 8 * lane + 512 * k + 4); }
    for (int t = gw; t < T; t += NGW) {
        f32x4 v[2][2]; float ss = 0.f;
#pragma unroll
        for (int k = 0; k < 2; ++k) { const size_t p = (size_t)t * DM + 8 * lane + 512 * k;
            v[k][0] = *(const GAS f32x4*)((const GAS float*)xin + p); v[k][1] = *(const GAS f32x4*)((const GAS float*)xin + p + 4);
            if (ADD_Y) {
                const u32x4 a = *(const GAS u32x4*)((const GAS bf16_t*)Y + p), c = *(const GAS u32x4*)((const GAS bf16_t*)Y + (size_t)T * DM + p);
                v[k][0] += (f32x4){bflo(a.x), bfhi(a.x), bflo(a.y), bfhi(a.y)} + (f32x4){bflo(c.x), bfhi(c.x), bflo(c.y), bfhi(c.y)};
                v[k][1] += (f32x4){bflo(a.z), bfhi(a.z), bflo(a.w), bfhi(a.w)} + (f32x4){bflo(c.z), bfhi(c.z), bflo(c.w), bfhi(c.w)};
                if (!FINAL) { *(GAS f32x4*)((GAS float*)xout + p) = v[k][0]; *(GAS f32x4*)((GAS float*)xout + p + 4) = v[k][1]; }
            }
#pragma unroll
            for (int q = 0; q < 2; ++q) ss += (v[k][q][0] * v[k][q][0] + v[k][q][1] * v[k][q][1]) + (v[k][q][2] * v[k][q][2] + v[k][q][3] * v[k][q][3]);
        }
        const float rstd = rsqrtf(wave_sum(ss) * (1.f / DM) + EPS);
#pragma unroll
        for (int k = 0; k < 2; ++k) { const size_t p = (size_t)t * DM + 8 * lane + 512 * k;
            const f32x4 a = v[k][0] * rstd * gv[k][0], c = v[k][1] * rstd * gv[k][1];
            if (FINAL) { *(GAS f32x4*)((GAS float*)OUT + p) = a; *(GAS f32x4*)((GAS float*)OUT + p + 4) = c; }
            else { u32x4 w; w.x = pk2(a[0], a[1]); w.y = pk2(a[2], a[3]); w.z = pk2(c[0], c[1]); w.w = pk2(c[2], c[3]); *(GAS u32x4*)((GAS bf16_t*)XN + p) = w; }
        }
    }
}
}

namespace moe {
constexpr int L_LOG = 0;
constexpr int L_HIST = 24576;
constexpr int L_TAB = 24576 + 256;
__device__ __forceinline__ void route_phase(LAS unsigned char* lds, const float* X1, const float* WR, const float* brg, const float* bre, const float* g2, int* EID, float* EW, float* RS2, int* CNT, bf16_t* XN2) {
    const int tid = ltid(), wid = tid >> 6, lane = tid & 63, r = lane & 15, q = lane >> 4;
    LAS float* lw = (LAS float*)(lds + L_LOG) + wid * (16 * 48);
    LAS int* hist = (LAS int*)(lds + L_HIST);
    f32x4 gv[2][2];
#pragma unroll
    for (int k = 0; k < 2; ++k) { gv[k][0] = *(const GAS f32x4*)((const GAS float*)g2 + 8 * lane + 512 * k); gv[k][1] = *(const GAS f32x4*)((const GAS float*)g2 + 8 * lane + 512 * k + 4); }
    for (int tile = lbid(); tile < T / 128; tile += gridDim.x) {
        __syncthreads();
        if (tid < 32) hist[tid] = 0;
        __syncthreads();
        const int t0 = tile * 128 + wid * 16;
        const GAS float* xp = (const GAS float*)X1 + (size_t)(t0 + r) * DM + 4 * q;
        const GAS float* wp = (const GAS float*)WR + (size_t)r * DM + 4 * q;
        f32x4 acc0 = {}, acc1 = {}, acc2 = {}; float ss = 0.f;
#pragma unroll 4
        for (int j = 0; j < 64; ++j) {
            const f32x4 a = *(const GAS f32x4*)(xp + 16 * j);
            const f32x4 b0 = *(const GAS f32x4*)(wp + 16 * j), b1 = *(const GAS f32x4*)(wp + 16 * DM + 16 * j), b2 = *(const GAS f32x4*)(wp + 32 * DM + 16 * j);
            ss += (a[0] * a[0] + a[1] * a[1]) + (a[2] * a[2] + a[3] * a[3]);
#pragma unroll
            for (int i = 0; i < 4; ++i) {
                acc0 = __builtin_amdgcn_mfma_f32_16x16x4f32(a[i], b0[i], acc0, 0, 0, 0);
                acc1 = __builtin_amdgcn_mfma_f32_16x16x4f32(a[i], b1[i], acc1, 0, 0, 0);
                acc2 = __builtin_amdgcn_mfma_f32_16x16x4f32(a[i], b2[i], acc2, 0, 0, 0); }
        }
#pragma unroll
        for (int i = 0; i < 4; ++i) { lw[(4 * q + i) * 48 + r] = acc0[i]; lw[(4 * q + i) * 48 + 16 + r] = acc1[i]; lw[(4 * q + i) * 48 + 32 + r] = acc2[i]; }
        ss += shflx(ss, 16); ss += shflx(ss, 32);
        const float rstd = rsqrtf(ss * (1.f / DM) + EPS);
        LDS_WAIT();
        if (lane < 16) {
            const int t = t0 + lane; const LAS float* lg = lw + lane * 48;
            float gl[4]; float gmax = -3.0e38f; int gi = 0;
#pragma unroll
            for (int i = 0; i < 4; ++i) { gl[i] = lg[i] * rstd + ((const GAS float*)brg)[i]; if (gl[i] > gmax) { gmax = gl[i]; gi = i; } }
            float gsum = 0.f;
#pragma unroll
            for (int i = 0; i < 4; ++i) gsum += __expf(gl[i] - gmax);
            const float grp_w = 1.f / gsum;
            float el[8]; float m0 = -3.0e38f; int i0 = 0;
#pragma unroll
            for (int i = 0; i < 8; ++i) { el[i] = lg[4 + gi * 8 + i] * rstd + ((const GAS float*)bre)[gi * 8 + i]; if (el[i] > m0) { m0 = el[i]; i0 = i; } }
            float m1 = -3.0e38f; int i1 = 0;
#pragma unroll
            for (int i = 0; i < 8; ++i) { if (i != i0 && el[i] > m1) { m1 = el[i]; i1 = i; } }
            const float p1 = __expf(m1 - m0), inv = 1.f / (1.f + p1);
            const int e0 = gi * 8 + i0, e1 = gi * 8 + i1;
            ((GAS int*)EID)[2 * t] = e0; ((GAS int*)EID)[2 * t + 1] = e1;
            ((GAS float*)EW)[2 * t] = grp_w * inv; ((GAS float*)EW)[2 * t + 1] = grp_w * p1 * inv;
            ((GAS float*)RS2)[t] = rstd;
            __hip_atomic_fetch_add(&hist[e0], 1, __ATOMIC_RELAXED, __HIP_MEMORY_SCOPE_WORKGROUP); __hip_atomic_fetch_add(&hist[e1], 1, __ATOMIC_RELAXED, __HIP_MEMORY_SCOPE_WORKGROUP);
        }
        for (int i = 0; i < 16; ++i) { const float rs = shfl_from(rstd, i);
#pragma unroll
            for (int k = 0; k < 2; ++k) { const size_t p = (size_t)(t0 + i) * DM + 8 * lane + 512 * k;
                const f32x4 a = *(const GAS f32x4*)((const GAS float*)X1 + p) * rs * gv[k][0], c = *(const GAS f32x4*)((const GAS float*)X1 + p + 4) * rs * gv[k][1];
                u32x4 w; w.x = pk2(a[0], a[1]); w.y = pk2(a[2], a[3]); w.z = pk2(c[0], c[1]); w.w = pk2(c[2], c[3]);
                *(GAS u32x4*)((GAS bf16_t*)XN2 + p) = w; } }
        __syncthreads();
        if (tid < 32) ((GAS int*)CNT)[tile * 32 + tid] = hist[tid];
    }
}
__device__ __forceinline__ void scatter_phase(LAS unsigned char* lds, const int* EID, const float* EW, const int* CNT, int* SRC, float* WGT, int* ROWTOK, int* TILEE) {
    const int tid = ltid();
    LAS int* ptot = (LAS int*)(lds + L_TAB); LAS int* pbef = ptot + 512; LAS int* base = pbef + 512; LAS int* segb = base + 32; LAS int* tot = segb + 32; LAS int* pe = tot + 32;
    for (int tile = lbid(); tile < T / 128; tile += gridDim.x) {
        __syncthreads();
        { const int e = tid & 31, part = tid >> 5; int s = 0, bf = 0;
          for (int i = 0; i < 16; ++i) { const int tt = part * 16 + i; const int c = ((const GAS int*)CNT)[tt * 32 + e]; s += c; bf += (tt < tile) ? c : 0; }
          ptot[part * 32 + e] = s; pbef[part * 32 + e] = bf; }
        if (tid < 256) pe[tid] = ((const GAS int*)EID)[tile * 256 + tid];
        __syncthreads();
        if (tid < 32) { int s = 0, bf = 0; for (int p = 0; p < 16; ++p) { s += ptot[p * 32 + tid]; bf += pbef[p * 32 + tid]; } tot[tid] = s; base[tid] = bf; }
        __syncthreads();
        if (tid == 0) { int run = 0; for (int e = 0; e < 32; ++e) { segb[e] = run; run += (tot[e] + 255) & ~255; } }
        __syncthreads();
        if (tid < 256) { const int me = pe[tid]; int rank = 0; for (int p = 0; p < 256; ++p) rank += (p < tid && pe[p] == me) ? 1 : 0;
            const int ps = segb[me] + base[me] + rank;
            ((GAS int*)SRC)[ps] = tile * 256 + tid; ((GAS float*)WGT)[ps] = ((const GAS float*)EW)[tile * 256 + tid]; ((GAS int*)ROWTOK)[ps] = tile * 128 + (tid >> 1); }
        for (int e = tile; e < 32; e += T / 128) {
            const int s0 = segb[e], n = tot[e], np = (n + 255) & ~255;
            for (int i = n + tid; i < np; i += 512) { ((GAS int*)SRC)[s0 + i] = -1; ((GAS int*)ROWTOK)[s0 + i] = 0; }
            for (int i = tid; i < np / 256; i += 512) ((GAS int*)TILEE)[s0 / 256 + i] = e;
            if (e == 31 && tid == 0) ((GAS int*)TILEE)[MT_MAX] = (s0 + np) / 256;
        }
    }
}
}

namespace pro {
constexpr int TSTR = 65;
template <class RowMap>
__device__ __forceinline__ void transpose_tile(LAS float* tile, const float* src, int N, int k0, int n0, const RowMap& rm, const float* kscale, bf16_t* dst, int ldd) {
    const int tid = ltid();
    { const int kk = tid >> 4, n4 = (tid & 15) * 4;
#pragma unroll
      for (int r = 0; r < 2; ++r) { const int k = kk + 32 * r; const f32x4 v = *(const GAS f32x4*)((const GAS float*)src + (size_t)(k0 + k) * N + n0 + n4);
          tile[k * TSTR + n4] = v[0]; tile[k * TSTR + n4 + 1] = v[1]; tile[k * TSTR + n4 + 2] = v[2]; tile[k * TSTR + n4 + 3] = v[3]; } }
    __syncthreads();
    { const int nn = tid >> 3, k8 = (tid & 7) * 8; const int drow = rm(n0 + nn);
      if (drow >= 0) { float v[8];
#pragma unroll
          for (int j = 0; j < 8; ++j) v[j] = tile[(k8 + j) * TSTR + nn] * (kscale ? ((const GAS float*)kscale)[k0 + k8 + j] : 1.f);
          u32x4 w; w.x = pk2(v[0], v[1]); w.y = pk2(v[2], v[3]); w.z = pk2(v[4], v[5]); w.w = pk2(v[6], v[7]);
          *(GAS u32x4*)((GAS bf16_t*)dst + (size_t)drow * ldd + k0 + k8) = w; } }
    __syncthreads();
}
struct MapIdent { __device__ int operator()(int c) const { return c; } };
struct MapWin { __device__ int operator()(int c) const {
    return c < RC_AF ? c : c < RC_AB ? PC_AF + (c - RC_AF) : c < RC_FU ? PC_AB + (c - RC_AB) : c < RC_CQ ? -1 : c < RC_CKV ? PC_CQ + (c - RC_CQ) : c < RC_KR ? PC_CKV + (c - RC_CKV) : PC_KR + (c - RC_KR); } };
struct MapWuq { __device__ int operator()(int c) const { const int head = c / 96, e = c - head * 96; if (e < 64) return c; const int i = e - 64;
    return head * 96 + 64 + 8 * ((i & 15) >> 2) + 4 * (i >> 4) + (i & 3); } };
struct MapGU { int type; __device__ int operator()(int h) const { return 256 * (h >> 7) + 128 * ((h >> 6) & 1) + 32 * ((h >> 4) & 3) + 8 * ((h >> 2) & 3) + 4 * type + (h & 3); } };

struct In {
    const float *x; const int* positions; const float *norm1_g, *w_in, *wa_f, *ba_f, *wa_b, *ba_b, *gla_ng, *fnet_w, *qn_g, *w_uq, *kvn_g, *w_ukv, *w_out, *norm2_g, *w_rg, *b_rg, *w_re, *b_re, *w_gate, *w_up, *w_down, *final_g;
};
__device__ __forceinline__ void tables_phase(const In& in, unsigned char* ws) {
    const int gt = lbid() * 512 + ltid(), NT = gridDim.x * 512;
    GAS float* FM = (GAS float*)(ws + WS_FM);
    for (int i = gt; i < 2 * 4 * 64 * 64; i += NT) { const int d = i & 63, c = (i >> 6) & 63, lg = i >> 12;
        const GAS float* wm = (const GAS float*)in.fnet_w + (size_t)lg * 4096 + d; float re = 0.f, im = 0.f;
        for (int cp = 0; cp < 64; ++cp) { float sn, cs; sincospif((float)((c * cp) & 63) * (1.f / 32.f), &sn, &cs); const float w = wm[cp * 64]; re = fmaf(cs, w, re); im = fmaf(-sn, w, im); }
        FM[(size_t)(lg * 64 + c) * 128 + d] = re * (1.f / 1024.f); FM[(size_t)(lg * 64 + c) * 128 + 64 + d] = im * (1.f / 1024.f); }
    GAS bf16_t* DW = (GAS bf16_t*)(ws + WS_DFTW);
    for (int i = gt; i < 128 * 128; i += NT) { const int n = i & 127, k = i >> 7; float sn, cs; sincospif((float)((k * n) & 127) * (1.f / 64.f), &sn, &cs);
        DW[i] = (bf16_t)f2bf(cs); DW[16384 + i] = (bf16_t)f2bf(-sn); DW[32768 + i] = (bf16_t)f2bf(sn); }
    GAS float* RP = (GAS float*)(ws + WS_ROPE);
    for (int i = gt; i < T * 16; i += NT) { const int f = i & 15, t = i >> 4;
        const double b4 = (f & 3) == 0 ? 1.0 : (f & 3) == 1 ? 0.5623413251903491 : (f & 3) == 2 ? 0.31622776601683794 : 0.1778279410038923;
        const double dc = (f >> 2) == 0 ? 1.0 : (f >> 2) == 1 ? 0.1 : (f >> 2) == 2 ? 0.01 : 0.001;
        const double turns = (double)((const GAS int*)in.positions)[t] * (b4 * dc) * 0.15915494309189535;
        const double fr = turns - __builtin_floor(turns);
        float sn, cs; sincospif((float)(2.0 * fr), &sn, &cs);
        RP[(size_t)t * 32 + f] = cs; RP[(size_t)t * 32 + 16 + f] = sn; }
}
__device__ __forceinline__ void weights_phase(LAS unsigned char* lds, const In& in, unsigned char* ws) {
    const int tid = ltid(); LAS float* tile = (LAS float*)lds;
    constexpr int J_WIN = 16 * 23, J_WUQ = 4 * 12, J_WUKV = 2 * 16, J_WOUT = 16 * 16, J_L = J_WIN + J_WUQ + J_WUKV + J_WOUT;
    for (int job = lbid(); job < 2 * J_L; job += gridDim.x) {
        const int l = job / J_L; int r = job - l * J_L;
        if (r < J_WIN) { transpose_tile(tile, in.w_in + (size_t)l * DM * IN_W, IN_W, (r / 23) * 64, (r % 23) * 64, MapWin{}, nullptr, (bf16_t*)(ws + WS_WIN) + (size_t)l * PW * DM, DM); continue; } r -= J_WIN;
        if (r < J_WUQ) { transpose_tile(tile, in.w_uq + (size_t)l * 256 * QW, QW, (r / 12) * 64, (r % 12) * 64, MapWuq{}, in.qn_g + l * 256, (bf16_t*)(ws + WS_WUQ) + (size_t)l * QW * 256, 256); continue; } r -= J_WUQ;
        if (r < J_WUKV) { transpose_tile(tile, in.w_ukv + (size_t)l * 128 * KVW, KVW, (r / 16) * 64, (r % 16) * 64, MapIdent{}, in.kvn_g + l * 128, (bf16_t*)(ws + WS_WUKV) + (size_t)l * KVW * 128, 128); continue; } r -= J_WUKV;
        transpose_tile(tile, in.w_out + (size_t)l * DM * DM, DM, (r / 16) * 64, (r % 16) * 64, MapIdent{}, nullptr, (bf16_t*)(ws + WS_WOUT) + (size_t)l * DM * DM, DM);
    }
    for (int job = lbid(); job < 2 * 4 * 16; job += gridDim.x) {
        const int kb = job & 15, g = (job >> 4) & 3, l = job >> 6;
        LAS float* wt = (LAS float*)lds; LAS float* mg = (LAS float*)(lds + 64 * TSTR * 4);
        __syncthreads();
        { const int kk = tid >> 4, c4 = (tid & 15) * 4;
#pragma unroll
          for (int r = 0; r < 2; ++r) { const int k = kk + 32 * r; const f32x4 v = *(const GAS f32x4*)((const GAS float*)in.w_in + ((size_t)l * DM + kb * 64 + k) * IN_W + RC_FU + g * 64 + c4);
              wt[k * TSTR + c4] = v[0]; wt[k * TSTR + c4 + 1] = v[1]; wt[k * TSTR + c4 + 2] = v[2]; wt[k * TSTR + c4 + 3] = v[3]; }
          const GAS float* fm = (const GAS float*)(ws + WS_FM) + (size_t)(l * 4 + g) * 8192;
#pragma unroll
          for (int r = 0; r < 16; ++r) mg[tid + 512 * r] = fm[tid + 512 * r]; }
        __syncthreads();
        { const int rho = tid & 127, kq = tid >> 7; float acc[16];
#pragma unroll
          for (int i = 0; i < 16; ++i) acc[i] = 0.f;
          for (int c = 0; c < 64; ++c) { const float m = mg[c * 128 + rho];
#pragma unroll
              for (int i = 0; i < 16; ++i) acc[i] = fmaf(wt[(kq * 16 + i) * TSTR + c], m, acc[i]); }
          GAS bf16_t* dp = (GAS bf16_t*)(ws + WS_WIN) + ((size_t)l * PW + PC_Z + g * 128 + rho) * DM + kb * 64 + kq * 16;
          u32x4 w0, w1; w0.x = pk2(acc[0], acc[1]); w0.y = pk2(acc[2], acc[3]); w0.z = pk2(acc[4], acc[5]); w0.w = pk2(acc[6], acc[7]);
          w1.x = pk2(acc[8], acc[9]); w1.y = pk2(acc[10], acc[11]); w1.z = pk2(acc[12], acc[13]); w1.w = pk2(acc[14], acc[15]);
          *(GAS u32x4*)dp = w0; *(GAS u32x4*)(dp + 8) = w1; }
    }
    const int gt = lbid() * 512 + tid, NT = gridDim.x * 512;
    for (int i = gt; i < 2 * 64 * DM / 8; i += NT) { const int l = i / (64 * DM / 8), r = i - l * (64 * DM / 8);
        *(GAS u32x4*)((GAS bf16_t*)(ws + WS_WIN) + ((size_t)l * PW + PC_PAD) * DM + (size_t)r * 8) = (u32x4){0u, 0u, 0u, 0u}; }
    for (int i = gt; i < 2 * 48 * DM; i += NT) { const int k = i & 1023, n = (i >> 10) % 48, l = i / (48 * DM);
        const float g2 = ((const GAS float*)in.norm2_g)[l * DM + k];
        const float w = n < 4 ? ((const GAS float*)in.w_rg)[((size_t)l * DM + k) * 4 + n] : n < 36 ? ((const GAS float*)in.w_re)[((size_t)l * DM + k) * 32 + (n - 4)] : 0.f;
        ((GAS float*)(ws + WS_WR))[i] = g2 * w; }
}
__device__ __forceinline__ void moe_weights_phase(LAS unsigned char* lds, const In& in, unsigned char* ws, int l) {
    LAS float* tile = (LAS float*)lds;
    for (int job = lbid(); job < 32 * 192; job += gridDim.x) {
        const int e = job / 192; int r = job - e * 192;
        const size_t eo = ((size_t)l * 32 + e) * DM * DEXP;
        bf16_t* gu = (bf16_t*)(ws + WS_WGU) + (size_t)e * 512 * DM; bf16_t* dn = (bf16_t*)(ws + WS_WD) + (size_t)e * DM * DEXP;
        if (r < 64) { transpose_tile(tile, in.w_gate + eo, DEXP, (r >> 2) * 64, (r & 3) * 64, MapGU{0}, nullptr, gu, DM); continue; } r -= 64;
        if (r < 64) { transpose_tile(tile, in.w_up + eo, DEXP, (r >> 2) * 64, (r & 3) * 64, MapGU{1}, nullptr, gu, DM); continue; } r -= 64;
        transpose_tile(tile, in.w_down + eo, DM, (r >> 4) * 64, (r & 15) * 64, MapIdent{}, nullptr, dn, DEXP);
    }
}
}

#ifdef SELFCHECK
namespace chk {
constexpr int NS = 48;
__device__ __forceinline__ float block_sum(float v, float* red) {
    v = wave_sum(v); __syncthreads(); if ((threadIdx.x & 63) == 0) red[threadIdx.x >> 6] = v; __syncthreads(); return red[0] + red[1] + red[2] + red[3];
}
__device__ __forceinline__ float block_max(float v, float* red) {
#pragma unroll
    for (int o = 1; o < 64; o <<= 1) v = fmaxf(v, __shfl_xor(v, o));
    __syncthreads(); if ((threadIdx.x & 63) == 0) red[threadIdx.x >> 6] = v; __syncthreads(); return fmaxf(fmaxf(red[0], red[1]), fmaxf(red[2], red[3]));
}
__device__ __forceinline__ void put_metric(unsigned char* ws, int id, float err, float ref_sq_sum, int n, float* red) {
    const float emax = block_max(err, red), rms = sqrtf(block_sum(ref_sq_sum, red) / (float)n + 1e-30f);
    if (threadIdx.x == 0) atomicMax((int*)(ws + WS_CTL + 49152) + id, __float_as_int(emax / rms));
}
__global__ void __launch_bounds__(256) check_kernel(pro::In in, unsigned char* ws) {
    __shared__ float xn[1024]; __shared__ float red[8]; __shared__ float vec[1024]; __shared__ float ored[4][64];
    const int tid = threadIdx.x, s = blockIdx.x, t = (int)(((long)s * 2731 + 77) % T), b = t / SEQ;
    const bf16_t* P = (const bf16_t*)(ws + WS_P); const unsigned char* Q = ws + WS_Q; const unsigned char* K8 = ws + WS_K8; const bf16_t* KV = (const bf16_t*)(ws + WS_KV); const unsigned char* KR = ws + WS_KR; const bf16_t* CAT = (const bf16_t*)(ws + WS_XN);
#define F8(p) __builtin_amdgcn_cvt_f32_fp8((int)(*(p)), 0)
    float* sc = (float*)(ws + WS_WGU) + (size_t)blockIdx.x * SEQ;
    { float ss = 0.f; for (int k = tid; k < 1024; k += 256) { const float v = in.x[(size_t)t * DM + k]; ss += v * v; }
      const float rstd = rsqrtf(block_sum(ss, red) / 1024.f + EPS);
      for (int k = tid; k < 1024; k += 256) xn[k] = in.x[(size_t)t * DM + k] * rstd * in.norm1_g[k]; }
    __syncthreads();
    { float err = 0.f, rsq = 0.f; int n = 0;
      for (int c = tid; c < IN_W; c += 256) { if (c >= RC_FU && c < RC_CQ) continue;
          const int pc = pro::MapWin{}(c); float ref = 0.f; for (int k = 0; k < 1024; ++k) ref = fmaf(xn[k], in.w_in[(size_t)k * IN_W + c], ref);
          err = fmaxf(err, fabsf(bf2f(P[(size_t)t * PW + pc]) - ref)); rsq += ref * ref; }
      put_metric(ws, 0, err, rsq, IN_W - 256, red); (void)n; }
    { for (int c = tid; c < 256; c += 256) { float u = 0.f; for (int k = 0; k < 1024; ++k) u = fmaf(xn[k], in.w_in[(size_t)k * IN_W + RC_FU + c], u); vec[c] = u; }
      __syncthreads();
      float err = 0.f, rsq = 0.f;
      for (int o = tid; o < 512; o += 256) { const int g = o >> 7, part = (o >> 6) & 1, d = o & 63; float ref = 0.f;
          for (int c = 0; c < 64; ++c) { float m = 0.f;
              for (int cp = 0; cp < 64; ++cp) { const float ang = -6.283185307179586f * (float)((c * cp) & 63) / 64.f; m = fmaf(part ? sinf(ang) : cosf(ang), in.fnet_w[(size_t)g * 4096 + cp * 64 + d], m); }
              ref = fmaf(vec[g * 64 + c], m * (1.f / 1024.f), ref); }
          err = fmaxf(err, fabsf(bf2f(P[(size_t)t * PW + PC_Z + o]) - ref)); rsq += ref * ref; }
      put_metric(ws, 1, err, rsq, 512, red); }
    { float ssq = 0.f, sskv = 0.f;
      for (int k = tid; k < 256; k += 256) { const float v = bf2f(P[(size_t)t * PW + PC_CQ + k]); ssq += v * v; }
      for (int k = tid; k < 128; k += 256) { const float v = bf2f(P[(size_t)t * PW + PC_CKV + k]); sskv += v * v; }
      const float rq = rsqrtf(block_sum(ssq, red) / 256.f + EPS), rkv = rsqrtf(block_sum(sskv, red) / 128.f + EPS);
      const double pos = (double)in.positions[t];
      float err = 0.f, rsq = 0.f;
      for (int c = tid; c < 768; c += 256) { float a = 0.f; for (int k = 0; k < 256; ++k) a = fmaf(bf2f(P[(size_t)t * PW + PC_CQ + k]) * in.qn_g[k], in.w_uq[(size_t)k * QW + c], a); vec[c] = a * rq; }
      __syncthreads();
      for (int c = tid; c < 768; c += 256) { const int h = c / 96, e = c % 96; float ref;
          if (e < 64) ref = vec[c];
          else { const int i = (e - 64) & 15; const double inv = exp2(-(double)i * (13.287712379549449 / 16.0)); const double ang = pos * inv; const double kk = rint(ang * 0.15915494309189535); const float r = (float)(ang - kk * 6.283185307179586);
                 const float cs = cosf(r), sn = sinf(r), x1 = vec[h * 96 + 64 + i], x2 = vec[h * 96 + 80 + i]; ref = (e < 80) ? x1 * cs - x2 * sn : x1 * sn + x2 * cs; }
          ref *= C2; err = fmaxf(err, fabsf(F8(Q + (size_t)t * QW + c) * (1.f / 16.f) - ref)); rsq += ref * ref; }
      put_metric(ws, 2, err, rsq, 768, red);
      err = 0.f; rsq = 0.f;
      for (int c = tid; c < 1024; c += 256) { float a = 0.f; for (int k = 0; k < 128; ++k) a = fmaf(bf2f(P[(size_t)t * PW + PC_CKV + k]) * in.kvn_g[k], in.w_ukv[(size_t)k * KVW + c], a);
          const float ref = a * rkv; if ((c & 127) < 64) err = fmaxf(err, fabsf(F8(K8 + ((size_t)t * 8 + (c >> 7)) * 64 + (c & 63)) - ref)); else err = fmaxf(err, fabsf(bf2f(KV[(size_t)t * 512 + (c >> 7) * 64 + (c & 63)]) - ref)); rsq += ref * ref; }
      put_metric(ws, 3, err, rsq, 1024, red);
      err = 0.f; rsq = 0.f;
      for (int c = tid; c < 32; c += 256) { const int i = c & 15; const double inv = exp2(-(double)i * (13.287712379549449 / 16.0)); const double ang = pos * inv; const double kk = rint(ang * 0.15915494309189535); const float r = (float)(ang - kk * 6.283185307179586);
          const float cs = cosf(r), sn = sinf(r), x1 = bf2f(P[(size_t)t * PW + PC_KR + i]), x2 = bf2f(P[(size_t)t * PW + PC_KR + 16 + i]);
          const float ref = (c < 16) ? x1 * cs - x2 * sn : x1 * sn + x2 * cs; err = fmaxf(err, fabsf(F8(KR + (size_t)t * 32 + c) - ref)); rsq += ref * ref; }
      put_metric(ws, 4, err, rsq, 32, red); }
    for (int h = 0; h < 8; ++h) {
        __syncthreads();
        if (tid < 96) vec[tid] = F8(Q + (size_t)t * QW + h * 96 + tid) * (1.f / 16.f);
        __syncthreads();
        float mx = -3e38f;
        for (int j = tid; j < SEQ; j += 256) { const size_t kt = (size_t)b * SEQ + j; float a = 0.f;
            for (int d = 0; d < 64; ++d) a = fmaf(vec[d], F8(K8 + (kt * 8 + h) * 64 + d), a);
            for (int d = 0; d < 32; ++d) a = fmaf(vec[64 + d], F8(KR + kt * 32 + d), a);
            sc[j] = a; mx = fmaxf(mx, a); }
        mx = block_max(mx, red);
        const int kg = tid >> 6, c = tid & 63; float o = 0.f, l = 0.f;
        for (int j = kg; j < SEQ; j += 4) { const float p = exp2f(sc[j] - mx); l += p; o = fmaf(p, bf2f(KV[((size_t)b * SEQ + j) * 512 + h * 64 + c]), o); }
        __syncthreads(); ored[kg][c] = o; if (c == 0) red[4 + kg] = l; __syncthreads();
        float err = 0.f, rsq = 0.f;
        if (tid < 64) { const float ref = (ored[0][tid] + ored[1][tid] + ored[2][tid] + ored[3][tid]) / (red[4] + red[5] + red[6] + red[7]);
            err = fabsf(bf2f(CAT[(size_t)t * DM + 512 + h * 64 + tid]) - ref); rsq = ref * ref; }
        put_metric(ws, 5, err, rsq, 64, red);
    }
}
}
#endif

constexpr int NWAVES = 8;
constexpr int LDS_MISC = 131072, LDS_BYTES = 147456;
constexpr int N_PHASES = 25;
struct Args { pro::In in; float* out; unsigned char* ws; int ph_lo, ph_hi, li, pad; };
static_assert(sizeof(Args) == 24 * 8 + 16 + 16, "Args has no padding");

__global__ void __launch_bounds__(NWAVES * 64, 2) fwd_kernel(Args args) {
    extern __shared__ __attribute__((aligned(16))) unsigned char lds_raw[];
    LAS unsigned char* lds = (LAS unsigned char*)lds_raw;
    const int tid = threadIdx.x;
    volatile LAS unsigned* misc = (volatile LAS unsigned*)(lds + LDS_MISC);
    if (tid < 64) misc[tid] = 0u;
    __syncthreads();
    XcdBarrier bar = xcd_barrier_post((unsigned*)(args.ws + WS_CTL) + 1024 + args.li * 4096, misc + 8);
    const int lo = args.ph_lo, hi = args.ph_hi;
#ifdef PREFIX_K
    const int skipm = args.pad;
#define SKIP(bit) ((skipm >> (bit)) & 1)
#else
#define SKIP(bit) 0
#endif
#ifndef PHMASK
#define PHMASK 0xFFFFFFFFu
#endif
#define IN(k) (((PHMASK >> ((k) < 2 ? (k) : 2 + ((k) - 2) % 11 + ((k) == 24 ? 11 : 0))) & 1u) && lo <= (k) && (k) < hi)
#ifndef DBL
#define DBL 0
#endif
#define REP(k) for (int rep_ = 0; rep_ < 1 + ((DBL >> (k)) & 1); ++rep_)
#ifndef SEAM_REPS
#define SEAM_REPS 1
#endif
#define SEAM(k) do { if (IN(k) && IN((k) + 1)) for (int sr_ = 0; sr_ < SEAM_REPS; ++sr_) xcd_barrier(bar); } while (0)
#define AS4 __attribute__((address_space(4)))
#define PH_BEGIN \
    unsigned long long kp_ = (unsigned long long)__builtin_amdgcn_kernarg_segment_ptr(); asm volatile("" : "+s"(kp_)); \
    const AS4 Args* ap_ = (const AS4 Args*)kp_; pro::In in; in.x = ap_->in.x; in.positions = ap_->in.positions; in.norm1_g = ap_->in.norm1_g; in.w_in = ap_->in.w_in; in.wa_f = ap_->in.wa_f; in.ba_f = ap_->in.ba_f; in.wa_b = ap_->in.wa_b; in.ba_b = ap_->in.ba_b; in.gla_ng = ap_->in.gla_ng; in.fnet_w = ap_->in.fnet_w; in.qn_g = ap_->in.qn_g; in.w_uq = ap_->in.w_uq; in.kvn_g = ap_->in.kvn_g; in.w_ukv = ap_->in.w_ukv; in.w_out = ap_->in.w_out; in.norm2_g = ap_->in.norm2_g; in.w_rg = ap_->in.w_rg; in.b_rg = ap_->in.b_rg; in.w_re = ap_->in.w_re; in.b_re = ap_->in.b_re; in.w_gate = ap_->in.w_gate; in.w_up = ap_->in.w_up; in.w_down = ap_->in.w_down; in.final_g = ap_->in.final_g; unsigned char* ws = ap_->ws; float* outp = ap_->out; (void)outp; \
    bf16_t* XN = (bf16_t*)(ws + WS_XN); bf16_t* CAT = XN; bf16_t* P = (bf16_t*)(ws + WS_P); bf16_t* Q = (bf16_t*)(ws + WS_Q); bf16_t* KV = (bf16_t*)(ws + WS_KV); bf16_t* KR = (bf16_t*)(ws + WS_KR); \
    float* X1 = (float*)(ws + WS_X1); float* S = (float*)(ws + WS_S); bf16_t* YP = (bf16_t*)(ws + WS_YP); float* DEC = (float*)(ws + WS_DEC); \
    float* ROPE = (float*)(ws + WS_ROPE); float* RSQ = (float*)(ws + WS_RSQ); float* RSKV = (float*)(ws + WS_RSKV); float* RS2 = (float*)(ws + WS_RS2); \
    int* EID = (int*)(ws + WS_EID); float* EW = (float*)(ws + WS_EW); int* CNT = (int*)(ws + WS_CNT); int* SRC = (int*)(ws + WS_SRC); float* WGT = (float*)(ws + WS_WGT); int* TILEE = (int*)(ws + WS_TILEE); \
    bf16_t* HE = (bf16_t*)(ws + WS_HE); bf16_t* Y = (bf16_t*)(ws + WS_Y); const bf16_t* DFTW = (const bf16_t*)(ws + WS_DFTW); \
    (void)XN; (void)CAT; (void)P; (void)Q; (void)KV; (void)KR; (void)X1; (void)S; (void)YP; (void)DEC; (void)ROPE; (void)RSQ; (void)RSKV; (void)RS2; (void)EID; (void)EW; (void)CNT; (void)SRC; (void)WGT; (void)TILEE; (void)HE; (void)Y; (void)DFTW; \
    const int G = gridDim.x, bid = lbid(); (void)G; (void)bid;
    if (IN(0)) { PH_BEGIN REP(19) pro::tables_phase(in, ws);
#ifdef TOUCH_WS
        { unsigned acc = 0; const int gt = lbid() * 512 + ltid(); for (size_t i = (size_t)gt * 4096; i < WS_END; i += (size_t)gridDim.x * 512 * 4096) acc += *(const GAS unsigned*)(ws + i);
          if (acc == 0x12345678u) *(GAS unsigned*)(ws + WS_CTL + 60000) = acc; }
#endif
    } SEAM(0);
    if (IN(1)) { PH_BEGIN REP(20) { pro::weights_phase(lds, in, ws); __syncthreads(); } } SEAM(1);

#pragma unroll 1
    for (int l = 0; l < DEPTH; ++l) {
        const int pb = 2 + 11 * l;
        if (IN(pb + 0)) { PH_BEGIN
            if (l == 0) REP(17) nrm::phase<false, false>(in.x, nullptr, nullptr, in.norm1_g, XN, nullptr);
            else nrm::phase<true, false>(X1, Y, X1, in.norm1_g + (size_t)l * DM, XN, nullptr);
        }
        SEAM(pb + 0);
        if (IN(pb + 1)) { PH_BEGIN
            pg8::Gemm g{XN, (const bf16_t*)(ws + WS_WIN) + (size_t)l * PW * DM, DM, DM, DM}; pg8::StaticOrder so; so.init(T, PW, G, bid);
            epi::Store E{P, PW, nullptr};
            REP(1) { pg8::gemm_phase<epi::Store, pg8::StaticOrder, true, true>(lds, g, so, E); __syncthreads(); }
        }
        SEAM(pb + 1);
        if (IN(pb + 2)) { PH_BEGIN
#ifndef SUBMASK
#define SUBMASK 7
#endif
            if ((SUBMASK & 2) && !SKIP(1)) { gla::load_consts(lds, in.wa_f + (size_t)l * 2048, in.ba_f + l * 128, in.wa_b + (size_t)l * 2048, in.ba_b + l * 128, in.gla_ng + l * 64);
            REP(3) for (int c = bid; c < BATCH * NCHUNK; c += G) gla::g1_unit(lds, P, S, DEC, c, ROPE, RSQ, RSKV, (unsigned char*)KR); }
            __syncthreads();
            if ((SUBMASK & 4) && !SKIP(2)) REP(4) { fnet::phase<1>(lds, P, YP, DFTW); __syncthreads(); }
        }
        SEAM(pb + 2);
        if (IN(pb + 3)) { PH_BEGIN
            if ((SUBMASK & 2) && !SKIP(4)) { pg8::Gemm g{P + PC_CQ, (const bf16_t*)(ws + WS_WUQ) + (size_t)l * QW * 256, 256, PW, 256}; pg8::StaticOrder so; so.init(T, QW, G, bid);
              epi::QRope E{(unsigned char*)Q, RSQ, ROPE};
              REP(5) { pg8::gemm_phase<epi::QRope, pg8::StaticOrder, true, true>(lds, g, so, E); __syncthreads(); } }
            __syncthreads();
            if ((SUBMASK & 4) && !SKIP(5)) { pg8::Gemm g{P + PC_CKV, (const bf16_t*)(ws + WS_WUKV) + (size_t)l * KVW * 128, 128, PW, 128}; pg8::StaticOrder so; so.init(T, KVW, G, bid);
              epi::StoreKV E{KV, ws + WS_K8, RSKV};
              REP(6) { pg8::gemm_phase<epi::StoreKV, pg8::StaticOrder, true, true>(lds, g, so, E); __syncthreads(); } }
        }
        SEAM(pb + 3);
        if (IN(pb + 4)) { PH_BEGIN gla::g2_scan(lds, S, DEC); att::vt_phase(lds, KV, ws + WS_V8T); }
        SEAM(pb + 4);
        if (IN(pb + 5)) { PH_BEGIN
            if ((SUBMASK & 1) && !SKIP(6)) { gla::load_consts(lds, in.wa_f + (size_t)l * 2048, in.ba_f + l * 128, in.wa_b + (size_t)l * 2048, in.ba_b + l * 128, in.gla_ng + l * 64);
            REP(7) for (int c = bid; c < BATCH * NCHUNK; c += G) gla::g3_unit(lds, P, S, CAT, c); }
            __syncthreads();
            if ((SUBMASK & 2) && !SKIP(7)) REP(8) { fnet::phase<2>(lds, YP, CAT, DFTW); __syncthreads(); }
            __syncthreads();
            if ((SUBMASK & 4) && !SKIP(8)) REP(9) { att::attn_phase<0>((const unsigned char*)Q, KV, ws + WS_K8, (const unsigned char*)KR, ws + WS_V8T, CAT, lds); __syncthreads(); }
#ifdef ATT_PROBE2
            att::attn_phase<ATT_PROBE2>((const unsigned char*)Q, KV, ws + WS_K8, (const unsigned char*)KR, ws + WS_V8T, (bf16_t*)outp, lds); __syncthreads();
#endif
        }
        SEAM(pb + 5);
        if (IN(pb + 6)) { PH_BEGIN
            pg8::Gemm g{CAT, (const bf16_t*)(ws + WS_WOUT) + (size_t)l * DM * DM, DM, DM, DM}; pg8::StaticOrder so; so.init(T, DM, G, bid);
            epi::Resid E{l == 0 ? in.x : X1, X1};
            pg8::gemm_phase<epi::Resid, pg8::StaticOrder, true, true>(lds, g, so, E);
            if (((DBL >> 16) & 1) && l == 0) { __syncthreads(); pg8::gemm_phase<epi::Resid, pg8::StaticOrder, true, true>(lds, g, so, E); }
        }
        SEAM(pb + 6);
        if (IN(pb + 7)) { PH_BEGIN
            REP(10) moe::route_phase(lds, X1, (const float*)(ws + WS_WR) + (size_t)l * 48 * DM, in.b_rg + l * 4, in.b_re + l * 32, in.norm2_g + (size_t)l * DM, EID, EW, RS2, CNT, XN);
            __syncthreads();
            REP(11) pro::moe_weights_phase(lds, in, ws, l);
        }
        SEAM(pb + 7);
        if (IN(pb + 8)) { PH_BEGIN REP(12) moe::scatter_phase(lds, EID, EW, CNT, SRC, WGT, (int*)(ws + WS_ROWTOK), TILEE); }
        SEAM(pb + 8);
        if (IN(pb + 9)) { PH_BEGIN
            const int ntile = ((const GAS int*)TILEE)[MT_MAX];
            pg8::Gemm g{XN, (const bf16_t*)(ws + WS_WGU), DM, DM, DM, (const int*)(ws + WS_ROWTOK)}; pg8::MoeOrder mo{TILEE, ntile, 2, G, bid};
            epi::GateUp E{HE};
            REP(13) { pg8::gemm_phase<epi::GateUp, pg8::MoeOrder, true, true, true>(lds, g, mo, E); __syncthreads(); }
        }
        SEAM(pb + 9);
        if (IN(pb + 10)) { PH_BEGIN
            const int ntile = ((const GAS int*)TILEE)[MT_MAX];
            pg8::Gemm g{HE, (const bf16_t*)(ws + WS_WD), DEXP, DEXP, DEXP}; pg8::MoeOrder mo{TILEE, ntile, 4, G, bid};
            epi::Down E{Y, SRC, WGT};
            REP(14) { pg8::gemm_phase<epi::Down, pg8::MoeOrder, true, true>(lds, g, mo, E); __syncthreads(); }
        }
        SEAM(pb + 10);
    }
    if (IN(24)) { PH_BEGIN REP(18) nrm::phase<true, true>(X1, Y, nullptr, in.final_g, nullptr, outp);
#ifdef SELFCHECK
        {
            __syncthreads(); VM_WAIT();
            const GAS float* met = (const GAS float*)(ws + WS_CTL + 49152); float m = 0.f;
            if (SELFCHECK < 0) { for (int i = 0; i < 8; ++i) m = fmaxf(m, met[i]); } else m = met[SELFCHECK];
            const float sc = 1.f + 10.f * m;
            const int gw = lbid() * 8 + (ltid() >> 6), NGW = gridDim.x * 8, lane = ltid() & 63;
            for (int t = gw; t < T; t += NGW) for (int k = 0; k < 16; ++k) ((GAS float*)outp)[(size_t)t * DM + lane + 64 * k] *= sc;
        }
#endif
    }
#undef IN
#undef SEAM
}

extern "C" void kernel_launch(void* const* d_in, const int* in_sizes, int n_in, void* d_out, int out_size, void* d_ws, size_t ws_size, hipStream_t stream) {
    static int grid = 0;
    if (grid == 0) {
        if (n_in != 24 || in_sizes[0] != T * DM || out_size != T * DM || ws_size < WS_END) { fprintf(stderr, "kernel_launch: shape / workspace mismatch (n_in %d, ws %zu < %zu?)\n", n_in, ws_size, (size_t)WS_END); grid = -1; return; }
        int dev = 0, cus = 0, per_cu = 0;
        if (hipGetDevice(&dev) != hipSuccess || hipDeviceGetAttribute(&cus, hipDeviceAttributeMultiprocessorCount, dev) != hipSuccess) { grid = -1; return; }
        if (hipFuncSetAttribute((const void*)fwd_kernel, hipFuncAttributeMaxDynamicSharedMemorySize, LDS_BYTES) != hipSuccess) { fprintf(stderr, "kernel_launch: hipFuncSetAttribute failed\n"); grid = -1; return; }
        if (hipOccupancyMaxActiveBlocksPerMultiprocessor(&per_cu, (const void*)fwd_kernel, NWAVES * 64, LDS_BYTES) != hipSuccess || per_cu < 1) { fprintf(stderr, "kernel_launch: occupancy query says %d\n", per_cu); }
        (void)hipGetLastError();
        grid = cus;
    }
    if (grid < 0) return;
    if (hipMemsetAsync((char*)d_ws + WS_CTL, 0, CTL_ZERO_BYTES, stream) != hipSuccess) return;
    Args a{};
    a.in.x = (const float*)d_in[0]; a.in.positions = (const int*)d_in[1]; a.in.norm1_g = (const float*)d_in[2]; a.in.w_in = (const float*)d_in[3];
    a.in.wa_f = (const float*)d_in[4]; a.in.ba_f = (const float*)d_in[5]; a.in.wa_b = (const float*)d_in[6]; a.in.ba_b = (const float*)d_in[7];
    a.in.gla_ng = (const float*)d_in[8]; a.in.fnet_w = (const float*)d_in[9]; a.in.qn_g = (const float*)d_in[10]; a.in.w_uq = (const float*)d_in[11];
    a.in.kvn_g = (const float*)d_in[12]; a.in.w_ukv = (const float*)d_in[13]; a.in.w_out = (const float*)d_in[14]; a.in.norm2_g = (const float*)d_in[15];
    a.in.w_rg = (const float*)d_in[16]; a.in.b_rg = (const float*)d_in[17]; a.in.w_re = (const float*)d_in[18]; a.in.b_re = (const float*)d_in[19];
    a.in.w_gate = (const float*)d_in[20]; a.in.w_up = (const float*)d_in[21]; a.in.w_down = (const float*)d_in[22]; a.in.final_g = (const float*)d_in[23];
    a.out = (float*)d_out; a.ws = (unsigned char*)d_ws;
#if defined(PREFIX_K)
#ifndef PREFIX_SKIP
#define PREFIX_SKIP 0
#endif
    a.ph_lo = 0; a.ph_hi = PREFIX_K; a.li = 0; a.pad = PREFIX_SKIP;
    hipLaunchKernelGGL(fwd_kernel, dim3(grid), dim3(NWAVES * 64), LDS_BYTES, stream, a);
    a.ph_lo = 0; a.ph_hi = N_PHASES; a.li = 1; a.pad = 0;
    hipLaunchKernelGGL(fwd_kernel, dim3(grid), dim3(NWAVES * 64), LDS_BYTES, stream, a);
#elif defined(SELFCHECK)
    a.ph_lo = 0; a.ph_hi = 8; a.li = 0;
    hipLaunchKernelGGL(fwd_kernel, dim3(grid), dim3(NWAVES * 64), LDS_BYTES, stream, a);
    hipLaunchKernelGGL(chk::check_kernel, dim3(chk::NS), dim3(256), 0, stream, a.in, (unsigned char*)d_ws);
    a.ph_lo = 8; a.ph_hi = N_PHASES; a.li = 1;
    hipLaunchKernelGGL(fwd_kernel, dim3(grid), dim3(NWAVES * 64), LDS_BYTES, stream, a);
#elif !defined(MK_SPLIT)
    a.ph_lo = 0; a.ph_hi = N_PHASES;
    hipLaunchKernelGGL(fwd_kernel, dim3(grid), dim3(NWAVES * 64), LDS_BYTES, stream, a);
#else
    for (int p = 0; p < N_PHASES; ++p) { a.ph_lo = p; a.ph_hi = p + 1; hipLaunchKernelGGL(fwd_kernel, dim3(grid), dim3(NWAVES * 64), LDS_BYTES, stream, a); }
#endif
    const hipError_t le = hipPeekAtLastError();
    if (le != hipSuccess) fprintf(stderr, "kernel_launch: launch failed: %s\n", hipGetErrorName(le));
}
```

```cpp
#include <hip/hip_runtime.h>
#include <cstdio>
#include <cstdint>

#define GAS __attribute__((address_space(1)))
#define LAS __attribute__((address_space(3)))
typedef unsigned short bf16_t;
typedef short bf16x8 __attribute__((ext_vector_type(8)));
typedef short s16x4 __attribute__((ext_vector_type(4)));
typedef float f32x2 __attribute__((ext_vector_type(2)));
typedef float f32x4 __attribute__((ext_vector_type(4)));
typedef float f32x16 __attribute__((ext_vector_type(16)));
typedef unsigned u32x2 __attribute__((ext_vector_type(2)));
typedef unsigned u32x4 __attribute__((ext_vector_type(4)));

constexpr int DM = 1024, BATCH = 2, SEQ = 16384, T = BATCH * SEQ, DEPTH = 2;
constexpr int IN_W = 1472;
constexpr int PW = 1536;
constexpr int PC_GQ = 0, PC_GK = 128, PC_GV = 256, PC_GG = 512, PC_U = 768, PC_CQ = 1024, PC_CKV = 1280, PC_KR = 1408, PC_AF = 1440, PC_AB = 1456, PC_PAD = 1472;
constexpr int PC_Z = PC_U;
constexpr int RC_GQ = 0, RC_GK = 128, RC_GV = 256, RC_GG = 512, RC_AF = 768, RC_AB = 784, RC_FU = 800, RC_CQ = 1056, RC_CKV = 1312, RC_KR = 1440;
constexpr int NH = 8, QKD = 96, QW = NH * QKD  , KVW = 1024;
constexpr float EPS = 1e-6f;
constexpr float C2 = 0.10206207261596577f * 1.4426950408889634f;
constexpr int NEXP = 32, DEXP = 256;
constexpr int MS_MAX = 2 * T + NEXP * 256;
constexpr int MT_MAX = MS_MAX / 256;
constexpr int NCHUNK = SEQ / 64;

constexpr size_t MiB = 1u << 20, KiB = 1024;
constexpr size_t WS_CTL = 0, CTL_ZERO_BYTES = 64 * KiB;
constexpr size_t WS_FM = 1 * MiB;
constexpr size_t WS_DFTW = WS_FM + 256 * KiB;
constexpr size_t WS_WR = WS_DFTW + 96 * KiB;
constexpr size_t WS_ROPE = 2 * MiB;
constexpr size_t WS_WIN = 6 * MiB;
constexpr size_t WS_WOUT = 13 * MiB;
constexpr size_t WS_WUQ = 17 * MiB;
constexpr size_t WS_WUKV = 18 * MiB;
constexpr size_t WS_EID = 19 * MiB;
constexpr size_t WS_EW = WS_EID + 256 * KiB;
constexpr size_t WS_RS2 = WS_EW + 256 * KiB;
constexpr size_t WS_RSQ = WS_RS2 + 128 * KiB;
constexpr size_t WS_RSKV = WS_RSQ + 128 * KiB;
constexpr size_t WS_CNT = WS_RSKV + 128 * KiB;
constexpr size_t WS_SRC = WS_CNT + 32 * KiB;
constexpr size_t WS_WGT = WS_SRC + 288 * KiB;
constexpr size_t WS_TILEE = WS_WGT + 288 * KiB;
constexpr size_t WS_DEC = WS_TILEE + 4 * KiB;
constexpr size_t WS_ROWTOK = WS_DEC + 512 * KiB;
constexpr size_t WS_RSS = WS_ROWTOK + 288 * KiB;
constexpr size_t WS_RSN = WS_RSS + 288 * KiB;
static_assert(WS_RSN + 128 * KiB <= 22 * MiB, "tables");
constexpr size_t WS_X1 = 22 * MiB;
constexpr size_t WS_XN = 150 * MiB;
constexpr size_t WS_P = 214 * MiB;
constexpr size_t WS_Q = 326 * MiB;
constexpr size_t WS_K8 = WS_Q + 24 * MiB;
constexpr size_t WS_KV = 374 * MiB;
constexpr size_t WS_V8T = WS_KV + 32 * MiB;
constexpr size_t WS_KR = 438 * MiB;
constexpr size_t WS_S = 440 * MiB;
constexpr size_t WS_YP = 472 * MiB;
constexpr size_t WS_HE = 294 * MiB;
constexpr size_t WS_Y = 330 * MiB;
constexpr size_t WS_WGU = 458 * MiB;
constexpr size_t WS_WD = 490 * MiB;
constexpr size_t WS_END = 506 * MiB;

#define LDS_WAIT() asm volatile("s_waitcnt lgkmcnt(0)" ::: "memory")
#define VM_WAIT() asm volatile("s_waitcnt vmcnt(0)" ::: "memory")
#define SBAR() __builtin_amdgcn_sched_barrier(0)
__device__ __forceinline__ unsigned f2bf(float f) { unsigned u = __builtin_bit_cast(unsigned, f); return (u + 0x7fffu + ((u >> 16) & 1u)) >> 16; }
__device__ __forceinline__ unsigned pk2(float lo, float hi) { return f2bf(lo) | (f2bf(hi) << 16); }
__device__ __forceinline__ float bf2f(unsigned short b) { return __builtin_bit_cast(float, (unsigned)b << 16); }
__device__ __forceinline__ float bflo(unsigned w) { return __builtin_bit_cast(float, w << 16); }
__device__ __forceinline__ float bfhi(unsigned w) { return __builtin_bit_cast(float, w & 0xffff0000u); }
__device__ __forceinline__ unsigned cvtpk(float lo, float hi) { unsigned r; asm volatile("v_cvt_pk_bf16_f32 %0, %1, %2" : "=v"(r) : "v"(lo), "v"(hi)); return r; }
__device__ __forceinline__ int crow(int r, int hi) { return (r & 3) + 8 * (r >> 2) + 4 * hi; }
__device__ __forceinline__ int ltid() { int t = threadIdx.x; asm volatile("" : "+v"(t)); return t; }
__device__ __forceinline__ int lbid() { int b = blockIdx.x; asm volatile("" : "+s"(b)); return b; }
__device__ __forceinline__ float shflx(float v, int o) { return __builtin_bit_cast(float, __builtin_amdgcn_ds_bpermute((((ltid() & 63) ^ o)) << 2, __builtin_bit_cast(int, v))); }
__device__ __forceinline__ float shfl_from(float v, int srclane) { return __builtin_bit_cast(float, __builtin_amdgcn_ds_bpermute(srclane << 2, __builtin_bit_cast(int, v))); }
__device__ __forceinline__ float wave_sum(float v) {
#pragma unroll
    for (int o = 1; o < 64; o <<= 1) v += shflx(v, o);
    return v;
}
typedef short v4i16_t __attribute__((ext_vector_type(4)));
__device__ __forceinline__ s16x4 vtr(const LAS unsigned char* p) { return __builtin_bit_cast(s16x4, __builtin_amdgcn_ds_read_tr16_b64_v4i16((LAS v4i16_t*)p)); }
__device__ __forceinline__ int tr_lane_off(int lane, int stride) { const int i = lane & 15; return ((lane >> 5) * 8 + (i >> 2)) * stride + (((lane >> 4) & 1) * 16 + (i & 3) * 4) * 2; }
__device__ __forceinline__ bf16x8 tr_frag(const LAS unsigned char* p, int stride) {
    const s16x4 a = vtr(p), b = vtr(p + 4 * stride);
    return (bf16x8){a[0], a[1], a[2], a[3], b[0], b[1], b[2], b[3]};
}
#define PK4(P, BASE, OUT) do { unsigned a0_ = cvtpk(P[BASE + 0], P[BASE + 1]), a1_ = cvtpk(P[BASE + 2], P[BASE + 3]);   \
    unsigned b0_ = cvtpk(P[BASE + 4], P[BASE + 5]), b1_ = cvtpk(P[BASE + 6], P[BASE + 7]);                              \
    auto r0_ = __builtin_amdgcn_permlane32_swap(a0_, b0_, false, false); auto r1_ = __builtin_amdgcn_permlane32_swap(a1_, b1_, false, false); \
    u32x4 w_ = {r0_[0], r1_[0], r0_[1], r1_[1]}; OUT = __builtin_bit_cast(bf16x8, w_); } while (0)

#define XB_TMO      128
#define XB_XCNT(j)  (256  + 64 * (j))
#define XB_XSUB(j)  (1280 + 64 * (j))
#define XB_XGEN(j)  (2304 + 64 * (j))
#define XB_TOP      3328
#define XB_TOPGEN   3392
#define XCD_BAR_WORDS 3456
#define XB_SPIN_CAP (1u << 22)

__device__ __forceinline__ unsigned xb_ld(unsigned* p)              { return __hip_atomic_load(p, __ATOMIC_RELAXED, __HIP_MEMORY_SCOPE_AGENT); }
__device__ __forceinline__ unsigned xb_add(unsigned* p, unsigned v) { return __hip_atomic_fetch_add(p, v, __ATOMIC_RELAXED, __HIP_MEMORY_SCOPE_AGENT); }
__device__ __forceinline__ unsigned xb_xcc_id() { return (unsigned)__builtin_amdgcn_s_getreg((3 << 11) | 20) & 0xFu; }
#define XB_SPIN(cond, bar) do { unsigned _sp = 0; while (cond) { __builtin_amdgcn_s_sleep(1); \
    if ((++_sp & 255u) == 0u) { if (xb_ld(&(bar)[XB_TMO])) break; if (_sp > XB_SPIN_CAP) { atomicAdd(&(bar)[XB_TMO], 1u); break; } } } } while (0)

struct XcdBarrier {
    unsigned* bar; unsigned x;
    volatile LAS unsigned* st;
};
__device__ __forceinline__ XcdBarrier xcd_barrier_post(unsigned* bar, volatile LAS unsigned* st) {
    XcdBarrier b; b.bar = bar; b.x = xb_xcc_id(); b.st = st;
    if (threadIdx.x == 0) (void)xb_add(&bar[XB_XCNT(b.x)], 1u);
    return b;
}
__device__ __forceinline__ void xcd_barrier_complete(unsigned* bar, unsigned x, unsigned& nloc, unsigned& nx) {
    const unsigned G = gridDim.x * gridDim.y * gridDim.z;
    unsigned sum, cnt, mine, sp = 0u;
    for (;;) {
        sum = 0u; cnt = 0u; mine = 0u;
#pragma unroll
        for (unsigned j = 0; j < 16; ++j) { const unsigned c = xb_ld(&bar[XB_XCNT(j)]); sum += c; cnt += (c > 0u) ? 1u : 0u; mine = (j == x) ? c : mine; }
        if (sum == G) break;
        __builtin_amdgcn_s_sleep(1);
        if ((++sp & 255u) == 0u) { if (xb_ld(&bar[XB_TMO])) break; if (sp > XB_SPIN_CAP) { atomicAdd(&bar[XB_TMO], 1u); break; } }
    }
    nloc = mine > 0u ? mine : 1u; nx = cnt > 0u ? cnt : 1u;
}
__device__ __forceinline__ void xcd_barrier(const XcdBarrier& b) {
    asm volatile("s_waitcnt vmcnt(0)" ::: "memory");
    __syncthreads();
    if (threadIdx.x == 0) {
        unsigned* bar = b.bar;
        __builtin_amdgcn_s_waitcnt(0);
        unsigned nloc = b.st[0], nx = b.st[1];
        if (nloc == 0u) { xcd_barrier_complete(bar, b.x, nloc, nx); b.st[0] = nloc; b.st[1] = nx; }
        const unsigned old = xb_add(&bar[XB_XSUB(b.x)], 1u);
        const unsigned gen = old / nloc;
        if (old + 1u == (gen + 1u) * nloc) {
            __builtin_amdgcn_fence(__ATOMIC_RELEASE, "agent");
            asm volatile("s_waitcnt vmcnt(0)" ::: "memory");
            const unsigned og = xb_add(&bar[XB_TOP], 1u);
            const unsigned tg = og / nx;
            if (og + 1u == (tg + 1u) * nx) xb_add(&bar[XB_TOPGEN], 1u);
            else XB_SPIN(xb_ld(&bar[XB_TOPGEN]) == tg, bar);
            __builtin_amdgcn_fence(__ATOMIC_ACQUIRE, "agent");
            xb_add(&bar[XB_XGEN(b.x)], 1u);
            asm volatile("s_waitcnt vmcnt(0)" ::: "memory");
        } else {
            XB_SPIN(xb_ld(&bar[XB_XGEN(b.x)]) == gen, bar);
            __builtin_amdgcn_fence(__ATOMIC_ACQUIRE, "agent");
            asm volatile("s_waitcnt vmcnt(0)" ::: "memory");
        }
    }
    __syncthreads();
}

namespace pg8 {
#define PG8_LAS __attribute__((address_space(3)))
constexpr int BM = 256, BK = 64, HALF = 128, HTB = HALF * BK * 2  , STAGE_BYTES = 8 * HTB, NXCD = 8, WGM = 8;
__host__ __device__ __forceinline__ int lds_byte(int r, int c) { const int st = (r >> 4) * 2 + (c >> 5), rr = r & 15, cc = c & 31, ob = rr * 64 + cc * 2; return st * 1024 + (ob ^ (((ob >> 9) & 1) << 5)); }
__host__ __device__ __forceinline__ void stage_rc(int b, int& R, int& C) { const int st = b / 1024, sb = b % 1024, swz = sb ^ (((sb >> 9) & 1) << 5); R = (st >> 1) * 16 + swz / 64; C = (st & 1) * 32 + (swz % 64) / 2; }
__host__ __device__ __forceinline__ int perm32(int rho) { const int n = rho >> 4, i = rho & 15; return 8 * (i >> 2) + 4 * n + (i & 3); }
struct Unit { int pm, pn; };
struct Gemm { const bf16_t* A; const bf16_t* Bt; int K, lda, ldb; const int* rowtok; };
struct StaticOrder {
    int nM, nN, nwg, G, c;
    __host__ __device__ void init(int M, int N, int G_, int c_) { nM = M / BM; nN = N / BM; nwg = nM * nN; G = G_; c = c_; }
    __host__ __device__ bool next(int i, Unit& u) const {
        const long L = (long)i * G + c; if (L >= nwg) return false;
        int wgid = (int)L; { const int q = nwg / NXCD, r = nwg % NXCD, xcd = wgid % NXCD, off = wgid / NXCD; wgid = (xcd < r ? xcd * (q + 1) : r * (q + 1) + (xcd - r) * q) + off; }
        const int nig = WGM * nN, gid = wgid / nig, fm = gid * WGM, gsz = (nM - fm) < WGM ? (nM - fm) : WGM;
        u.pm = fm + ((wgid % nig) % gsz); u.pn = (wgid % nig) / gsz; return true;
    }
    __device__ __forceinline__ void a_ready(const Unit&) const {}
    __device__ __forceinline__ void done(const Unit&) const {}
};
struct MoeOrder {
    const int* te; int ntile, ncol, G, c;
    __device__ bool next(int i, Unit& u) const {
        const long L = (long)i * G + c; if (L >= (long)ntile * ncol) return false;
        const int pm = (int)(L / ncol), j = (int)(L % ncol); u.pm = pm; u.pn = te[pm] * ncol + j; return true;
    }
    __device__ __forceinline__ void a_ready(const Unit&) const {}
    __device__ __forceinline__ void done(const Unit&) const {}
};
__device__ __forceinline__ void grid_arrive(unsigned* cnt) {
    asm volatile("s_waitcnt vmcnt(0)" ::: "memory");
    __syncthreads();
    if (threadIdx.x == 0) { __builtin_amdgcn_fence(__ATOMIC_RELEASE, "agent"); asm volatile("s_waitcnt vmcnt(0)" ::: "memory"); (void)xb_add(cnt, 1u); }
}
__device__ __forceinline__ void grid_wait(unsigned* cnt, unsigned target) {
    if (threadIdx.x == 0) { unsigned sp = 0u; while (xb_ld(cnt) < target) { __builtin_amdgcn_s_sleep(1); if (++sp > XB_SPIN_CAP) break; }
        __builtin_amdgcn_fence(__ATOMIC_ACQUIRE, "agent"); asm volatile("s_waitcnt vmcnt(0)" ::: "memory"); }
    __syncthreads();
}
struct MoeOrderA {
    const int* te; int ntile, G, c; unsigned* cntA;
    __device__ bool next(int i, Unit& u) const {
        const long L = (long)i * G + c; if (L >= (long)ntile * 2) return false;
        const int pm = (int)(L >> 1), j = (int)(L & 1); u.pm = pm; u.pn = te[pm] * 2 + j; return true;
    }
    __device__ __forceinline__ void a_ready(const Unit&) const {}
    __device__ __forceinline__ void done(const Unit& u) const { const int L = u.pm * 2 + (u.pn & 1); if (L >= G && L < 2 * G) grid_arrive(cntA); }
};
struct DownOrder {
    const int* te; int first, stride, limit;
    __device__ bool next(int i, Unit& u) const {
        const long L = (long)first + (long)i * stride; if (L >= limit) return false;
        const int pm = (int)(L >> 2), j = (int)(L & 3); u.pm = pm; u.pn = te[pm] * 4 + j; return true;
    }
    __device__ __forceinline__ void a_ready(const Unit&) const {}
    __device__ __forceinline__ void done(const Unit&) const {}
};
template <class Epi, class Sched, bool ALIGN_EPI = false, bool SP2 = false, bool GATHER = false>
__device__ __forceinline__ void gemm_phase(PG8_LAS unsigned char* lds, const Gemm g, const Sched& S, const Epi& E) {
    const int tid = ltid(), wid = __builtin_amdgcn_readfirstlane(tid >> 6), lane = tid & 63, wr = wid >> 2, wc = wid & 3, fr = lane & 15, fq = lane >> 4;
    int K_ = g.K; asm volatile("" : "+s"(K_));
    const int K = K_, nt = K / BK;
    unsigned voffA[2], voffB[2];
#pragma unroll
    for (int i = 0; i < 2; ++i) { int R, C; stage_rc(tid * 16 + i * 8192, R, C);
        const int Rb = Epi::WIDE ? (64 * (R >> 5) + 16 * ((R & 15) >> 2) + 4 * ((R >> 4) & 1) + (R & 3)) : Epi::PERM ? ((R & ~31) + perm32(R & 31)) : R;
        voffA[i] = (unsigned)(R * g.lda + C) * 2u; voffB[i] = (unsigned)(Rb * g.ldb + C) * 2u; }
    static_assert(!GATHER || SP2, "GATHER is implemented on the SP2 loop");
    int gR[2]; unsigned gC[2]; unsigned cG0[2] = {0u, 0u}, cG1[2] = {0u, 0u}, nG0[2] = {0u, 0u}, nG1[2] = {0u, 0u};
#pragma unroll
    for (int i = 0; i < 2; ++i) { int R, C; stage_rc(tid * 16 + i * 8192, R, C); gR[i] = R; gC[i] = (unsigned)C * 2u; }
#define PG8_GLOAD(G0, G1, u) do { if constexpr (GATHER) { _Pragma("unroll") for (int _i = 0; _i < 2; ++_i) { \
        G0[_i] = (unsigned)((const GAS int*)g.rowtok)[(u).pm * 256 + gR[_i]] * (unsigned)(g.lda * 2) + gC[_i]; \
        G1[_i] = (unsigned)((const GAS int*)g.rowtok)[(u).pm * 256 + 128 + gR[_i]] * (unsigned)(g.lda * 2) + gC[_i]; } } } while (0)
    const size_t kstep = (size_t)(BK * 2);
    const size_t hstepA = (size_t)HALF * g.lda * 2, hstepB = (size_t)(Epi::WIDE ? 8 : HALF) * g.ldb * 2;
    const size_t tstepA = 2 * hstepA, tstepB = (size_t)BM * g.ldb * 2;
    const unsigned ldsw = (unsigned)wid * 1024u;
    const int aoff = lds_byte(wr * 64 + fr, fq * 8), boff = lds_byte(wc * 32 + fr, fq * 8);
#define PG8_SA(b, h) (((b) * 2 + (h)) * HTB)
#define PG8_SB(b, h) ((4 + (b) * 2 + (h)) * HTB)
#define PG8_STAGE(bufoff, gbase, voff) do { _Pragma("unroll") for (int _i = 0; _i < 2; ++_i) \
        __builtin_amdgcn_global_load_lds((const unsigned*)((const char*)(gbase) + (voff)[_i]), (PG8_LAS unsigned*)(lds + (bufoff) + ldsw + _i * 8192), 16, 0, 0); } while (0)
#define PG8_LDA(dst, b, h) do { _Pragma("unroll") for (int m = 0; m < 4; ++m) _Pragma("unroll") for (int k = 0; k < 2; ++k) dst[m][k] = *(const PG8_LAS bf16x8*)(lds + PG8_SA(b, h) + aoff + m * 2048 + k * 1024); } while (0)
#define PG8_LDB(dst, b, h) do { _Pragma("unroll") for (int n = 0; n < 2; ++n) _Pragma("unroll") for (int k = 0; k < 2; ++k) dst[n][k] = *(const PG8_LAS bf16x8*)(lds + PG8_SB(b, h) + boff + n * 2048 + k * 1024); } while (0)
#define PG8_MMA(ai, bj, At, Bt) do { __builtin_amdgcn_s_setprio(1); _Pragma("unroll") for (int m = 0; m < 4; ++m) _Pragma("unroll") for (int n = 0; n < 2; ++n) _Pragma("unroll") for (int k = 0; k < 2; ++k) \
        acc[ai][bj][m][n] = __builtin_amdgcn_mfma_f32_16x16x32_bf16(Bt[n][k], At[m][k], acc[ai][bj][m][n], 0, 0, 0); __builtin_amdgcn_s_setprio(0); } while (0)
#define PG8_WAIT_V(n) asm volatile("s_waitcnt vmcnt(" #n ")" ::: "memory")
#define PG8_WAIT_L(n) asm volatile("s_waitcnt lgkmcnt(" #n ")" ::: "memory")
#define PG8_BAR __builtin_amdgcn_s_barrier()
#define PG8_SCHED __builtin_amdgcn_sched_barrier(0)
    Unit cur, nxt; int ui = 0;
    if (!S.next(0, cur)) return;
    f32x4 acc[2][2][4][2];
#pragma unroll
    for (int a = 0; a < 2; ++a)
#pragma unroll
        for (int b = 0; b < 2; ++b)
#pragma unroll
            for (int m = 0; m < 4; ++m)
#pragma unroll
                for (int n = 0; n < 2; ++n) acc[a][b][m][n] = (f32x4){0.f, 0.f, 0.f, 0.f};
    bf16x8 At[4][2], B0[2][2], B1[2][2];
    const char* cA = (const char*)g.A + (GATHER ? (size_t)0 : (size_t)cur.pm * tstepA); const char* cB = (const char*)g.Bt + (size_t)cur.pn * tstepB;
    S.a_ready(cur);
    PG8_GLOAD(cG0, cG1, cur);
#define PG8_STA(bufoff, P, half, SEL) do { if constexpr (GATHER) { PG8_STAGE(bufoff, P, (SEL) ? ((half) ? sG1 : sG0) : ((half) ? cG1 : cG0)); } else { PG8_STAGE(bufoff, (P) + ((half) ? hstepA : (size_t)0), voffA); } } while (0)
    unsigned sG0[2] = {0u, 0u}, sG1[2] = {0u, 0u};
    if constexpr (SP2) {
        PG8_STAGE(PG8_SB(0, 0), cB, voffB); PG8_STAGE(PG8_SB(0, 1), cB + hstepB, voffB); PG8_STA(PG8_SA(0, 0), cA, 0, false); PG8_STA(PG8_SA(0, 1), cA, 1, false);
        PG8_STAGE(PG8_SB(1, 0), cB + kstep, voffB); PG8_STA(PG8_SA(1, 0), cA + kstep, 0, false); PG8_STAGE(PG8_SB(1, 1), cB + hstepB + kstep, voffB);
        if (wr == 1) PG8_BAR;
        PG8_WAIT_V(8); PG8_BAR;
        PG8_WAIT_V(6); PG8_BAR;
    } else {
        PG8_STAGE(PG8_SB(0, 0), cB, voffB); PG8_STAGE(PG8_SA(0, 0), cA, voffA); PG8_STAGE(PG8_SB(0, 1), cB + hstepB, voffB); PG8_STAGE(PG8_SA(0, 1), cA + hstepA, voffA);
        if (wr == 1) PG8_BAR;
        PG8_WAIT_V(4); PG8_BAR;
        PG8_STAGE(PG8_SB(1, 0), cB + kstep, voffB); PG8_STAGE(PG8_SA(1, 0), cA + kstep, voffA); PG8_STAGE(PG8_SB(1, 1), cB + hstepB + kstep, voffB);
        PG8_WAIT_V(6); PG8_BAR;
    }
    for (;;) {
        const bool has_next = S.next(ui + 1, nxt);
        if (has_next) PG8_GLOAD(nG0, nG1, nxt);
        const char* nA = (has_next && !GATHER) ? (const char*)g.A + (size_t)nxt.pm * tstepA : cA; const char* nB = has_next ? (const char*)g.Bt + (size_t)nxt.pn * tstepB : cB;
#pragma clang loop unroll(disable)
        for (int t = 0; t < nt; t += 2) {
            const bool last = (t == nt - 2);
            const char* a1 = cA + (size_t)(t + 1) * kstep;
            const char* a2 = last ? nA : cA + (size_t)(t + 2) * kstep; const char* b2 = last ? nB : cB + (size_t)(t + 2) * kstep;
            const char* a3 = a2 + kstep; const char* b3 = b2 + kstep;
            if (last && has_next) S.a_ready(nxt);
            if constexpr (GATHER) { _Pragma("unroll") for (int _i = 0; _i < 2; ++_i) { sG0[_i] = cG0[_i]; sG1[_i] = cG1[_i]; } if (last && has_next) { _Pragma("unroll") for (int _i = 0; _i < 2; ++_i) { sG0[_i] = nG0[_i]; sG1[_i] = nG1[_i]; } } }
            if constexpr (SP2) {
            PG8_LDB(B0, 0, 0); PG8_LDB(B1, 0, 1); PG8_SCHED; PG8_LDA(At, 0, 0); PG8_STA(PG8_SA(1, 1), a1, 1, false);
            PG8_WAIT_V(8); PG8_WAIT_L(0); PG8_BAR; PG8_MMA(0, 0, At, B0); PG8_MMA(0, 1, At, B1); PG8_BAR; PG8_SCHED;
            PG8_LDA(At, 0, 1); PG8_STAGE(PG8_SB(0, 0), b2, voffB); PG8_STAGE(PG8_SB(0, 1), b2 + hstepB, voffB); PG8_STA(PG8_SA(0, 0), a2, 0, true);
            PG8_WAIT_V(8); PG8_WAIT_L(0); PG8_BAR; PG8_MMA(1, 0, At, B0); PG8_MMA(1, 1, At, B1); PG8_BAR; PG8_SCHED;
            PG8_LDB(B0, 1, 0); PG8_LDB(B1, 1, 1); PG8_SCHED; PG8_LDA(At, 1, 0); PG8_STA(PG8_SA(0, 1), a2, 1, true);
            PG8_WAIT_V(8); PG8_WAIT_L(0); PG8_BAR; PG8_MMA(0, 0, At, B0); PG8_MMA(0, 1, At, B1); PG8_BAR; PG8_SCHED;
            PG8_LDA(At, 1, 1); PG8_STAGE(PG8_SB(1, 0), b3, voffB); PG8_STAGE(PG8_SB(1, 1), b3 + hstepB, voffB); PG8_STA(PG8_SA(1, 0), a3, 0, true);
            PG8_WAIT_V(8); PG8_WAIT_L(0); PG8_BAR; PG8_MMA(1, 0, At, B0); PG8_MMA(1, 1, At, B1); PG8_BAR; PG8_SCHED;
            } else {
            PG8_LDB(B0, 0, 0); PG8_SCHED; PG8_LDA(At, 0, 0); PG8_STAGE(PG8_SA(1, 1), a1 + hstepA, voffA);
            PG8_WAIT_L(8); PG8_BAR; PG8_WAIT_L(0); PG8_MMA(0, 0, At, B0); PG8_BAR; PG8_SCHED;
            PG8_LDB(B1, 0, 1); PG8_STAGE(PG8_SB(0, 0), b2, voffB);
            PG8_BAR; PG8_WAIT_L(0); PG8_MMA(0, 1, At, B1); PG8_BAR;
            PG8_LDA(At, 0, 1); PG8_STAGE(PG8_SA(0, 0), a2, voffA);
            PG8_BAR; PG8_WAIT_L(0); PG8_MMA(1, 0, At, B0); PG8_BAR; PG8_SCHED;
            PG8_STAGE(PG8_SB(0, 1), b2 + hstepB, voffB);
            PG8_WAIT_V(6); PG8_BAR; PG8_MMA(1, 1, At, B1); PG8_BAR;
            PG8_LDB(B0, 1, 0); PG8_SCHED; PG8_LDA(At, 1, 0); PG8_STAGE(PG8_SA(0, 1), a2 + hstepA, voffA);
            PG8_WAIT_L(8); PG8_BAR; PG8_WAIT_L(0); PG8_MMA(0, 0, At, B0); PG8_BAR; PG8_SCHED;
            PG8_LDB(B1, 1, 1); PG8_STAGE(PG8_SB(1, 0), b3, voffB);
            PG8_BAR; PG8_WAIT_L(0); PG8_MMA(0, 1, At, B1); PG8_BAR;
            PG8_LDA(At, 1, 1); PG8_STAGE(PG8_SA(1, 0), a3, voffA);
            PG8_BAR; PG8_WAIT_L(0); PG8_MMA(1, 0, At, B0); PG8_BAR; PG8_SCHED;
            PG8_STAGE(PG8_SB(1, 1), b3 + hstepB, voffB);
            PG8_WAIT_V(6); PG8_BAR; PG8_MMA(1, 1, At, B1); PG8_BAR;
            }
        }
        if constexpr (ALIGN_EPI) { if (wr == 0) PG8_BAR; }
        if constexpr (!Epi::AFTER_DRAIN) { E(acc, cur, wr, wc, fr, fq); S.done(cur); }
        if (!has_next) break;
#pragma unroll
        for (int a = 0; a < 2; ++a)
#pragma unroll
            for (int b = 0; b < 2; ++b)
#pragma unroll
                for (int m = 0; m < 4; ++m)
#pragma unroll
                    for (int n = 0; n < 2; ++n) acc[a][b][m][n] = (f32x4){0.f, 0.f, 0.f, 0.f};
        cur = nxt; cA = nA; cB = nB; ++ui;
        if constexpr (GATHER) { _Pragma("unroll") for (int _i = 0; _i < 2; ++_i) { cG0[_i] = nG0[_i]; cG1[_i] = nG1[_i]; } }
        if constexpr (ALIGN_EPI) { if (wr == 1) PG8_BAR; }
    }
    PG8_WAIT_V(0);
    if constexpr (!ALIGN_EPI) { if (wr == 0) PG8_BAR; }
    PG8_BAR;
    if constexpr (Epi::AFTER_DRAIN) { E.fused(acc, cur, wr, wc, fr, fq, lds, wid, lane); S.done(cur); }
#undef PG8_SA
#undef PG8_SB
#undef PG8_STAGE
#undef PG8_STA
#undef PG8_GLOAD
#undef PG8_LDA
#undef PG8_LDB
#undef PG8_MMA
#undef PG8_WAIT_V
#undef PG8_WAIT_L
#undef PG8_BAR
#undef PG8_SCHED
}
}

namespace epi {
using pg8::Unit;
__device__ __forceinline__ u32x4 pack8(f32x4 a, f32x4 b) { u32x4 w; w.x = cvtpk(a[0], a[1]); w.y = cvtpk(a[2], a[3]); w.z = cvtpk(b[0], b[1]); w.w = cvtpk(b[2], b[3]); return w; }
__device__ __forceinline__ u32x2 pack4(f32x4 a) { u32x2 w; w.x = cvtpk(a[0], a[1]); w.y = cvtpk(a[2], a[3]); return w; }

struct Store {
    static constexpr bool PERM = true, WIDE = true, AFTER_DRAIN = false;
    bf16_t* O; int ldc; const float* rowscale;
    __device__ __forceinline__ void operator()(const f32x4 (&acc)[2][2][4][2], const Unit& u, int wr, int wc, int fr, int fq) const {
        int pm_ = u.pm, pn_ = u.pn, lrow_ = wr * 64 + fr, lcol_ = wc * 64 + 16 * fq;
        asm volatile("" : "+s"(pm_), "+s"(pn_), "+v"(lrow_), "+v"(lcol_));
#pragma unroll
        for (int ai = 0; ai < 2; ++ai)
#pragma unroll
            for (int m = 0; m < 4; ++m) {
                const int row = pm_ * 256 + ai * 128 + m * 16 + lrow_;
                const float sc = rowscale ? ((const GAS float*)rowscale)[row] : 1.f;
                GAS bf16_t* rp = (GAS bf16_t*)O + (size_t)row * ldc + pn_ * 256 + lcol_;
#pragma unroll
                for (int bj = 0; bj < 2; ++bj) *(GAS u32x4*)(rp + bj * 8) = pack8(acc[ai][bj][m][0] * sc, acc[ai][bj][m][1] * sc);
            }
    }
};
__device__ __forceinline__ unsigned pk4_fp8(f32x4 v) { int w = 0; w = __builtin_amdgcn_cvt_pk_fp8_f32(v[0], v[1], w, false); w = __builtin_amdgcn_cvt_pk_fp8_f32(v[2], v[3], w, true); return (unsigned)w; }
struct QRope {
    static constexpr bool PERM = true, WIDE = true, AFTER_DRAIN = false;
    unsigned char* Q; const float* rsq; const float* rope;
    __device__ __forceinline__ void operator()(const f32x4 (&acc)[2][2][4][2], const Unit& u, int wr, int wc, int fr, int fq) const {
        int pm_ = u.pm, g_ = 4 * u.pn + wc, lrow_ = wr * 64 + fr, fq_ = fq;
        asm volatile("" : "+s"(pm_), "+s"(g_), "+v"(lrow_), "+v"(fq_));
#pragma unroll
        for (int ai = 0; ai < 2; ++ai)
#pragma unroll
            for (int m = 0; m < 4; ++m) {
                const int row = pm_ * 256 + ai * 128 + m * 16 + lrow_;
                const float sc = ((const GAS float*)rsq)[row] * (C2 * 16.f);
                GAS unsigned char* rp = (GAS unsigned char*)Q + (size_t)row * QW;
                const f32x4 a0 = acc[ai][0][m][0] * sc, a1 = acc[ai][0][m][1] * sc, b0 = acc[ai][1][m][0] * sc, b1 = acc[ai][1][m][1] * sc;
                if (g_ < 8) { u32x4 w; w.x = pk4_fp8(a0); w.y = pk4_fp8(a1); w.z = pk4_fp8(b0); w.w = pk4_fp8(b1); *(GAS u32x4*)(rp + g_ * 96 + 16 * fq_) = w; }
                else {
                    const int head = 2 * (g_ - 8) + (fq_ >> 1), idx = 8 * (fq_ & 1);
                    const GAS float* cp = (const GAS float*)rope + (size_t)row * 32 + idx;
                    const f32x4 c0 = *(const GAS f32x4*)cp, c1 = *(const GAS f32x4*)(cp + 4), s0 = *(const GAS f32x4*)(cp + 16), s1 = *(const GAS f32x4*)(cp + 20);
                    u32x2 o1, o2; o1.x = pk4_fp8(a0 * c0 - b0 * s0); o1.y = pk4_fp8(a1 * c1 - b1 * s1); o2.x = pk4_fp8(a0 * s0 + b0 * c0); o2.y = pk4_fp8(a1 * s1 + b1 * c1);
                    *(GAS u32x2*)(rp + head * 96 + 64 + idx) = o1; *(GAS u32x2*)(rp + head * 96 + 80 + idx) = o2;
                }
            }
    }
};
struct StoreKV {
    static constexpr bool PERM = true, WIDE = true, AFTER_DRAIN = false;
    unsigned char* V8; unsigned char* K8; const float* rowscale;
    __device__ __forceinline__ void operator()(const f32x4 (&acc)[2][2][4][2], const Unit& u, int wr, int wc, int fr, int fq) const {
        int pm_ = u.pm, head_ = u.pn * 2 + (wc >> 1), isv_ = wc & 1, lrow_ = wr * 64 + fr, c16_ = 16 * fq;
        asm volatile("" : "+s"(pm_), "+s"(head_), "+s"(isv_), "+v"(lrow_), "+v"(c16_));
#pragma unroll
        for (int ai = 0; ai < 2; ++ai)
#pragma unroll
            for (int m = 0; m < 4; ++m) {
                const int row = pm_ * 256 + ai * 128 + m * 16 + lrow_;
                const float sc = ((const GAS float*)rowscale)[row];
                const f32x4 a0 = acc[ai][0][m][0] * sc, a1 = acc[ai][0][m][1] * sc, b0 = acc[ai][1][m][0] * sc, b1 = acc[ai][1][m][1] * sc;
                u32x4 w; w.x = pk4_fp8(a0); w.y = pk4_fp8(a1); w.z = pk4_fp8(b0); w.w = pk4_fp8(b1);
                *(GAS u32x4*)((GAS unsigned char*)(isv_ ? V8 : K8) + ((size_t)row * 8 + head_) * 64 + c16_) = w;
            }
    }
};
struct GateUp {
    static constexpr bool PERM = true, WIDE = true, AFTER_DRAIN = false;
    bf16_t* HE; const float* rss;
    __device__ __forceinline__ void operator()(const f32x4 (&acc)[2][2][4][2], const Unit& u, int wr, int wc, int fr, int fq) const {
        int pm_ = u.pm, pn_ = u.pn, lrow_ = wr * 64 + fr, lcol_ = wc * 32 + 8 * fq;
        asm volatile("" : "+s"(pm_), "+s"(pn_), "+v"(lrow_), "+v"(lcol_));
        const int j = pn_ & 1;
#pragma unroll
        for (int ai = 0; ai < 2; ++ai)
#pragma unroll
            for (int m = 0; m < 4; ++m) {
                const int row = pm_ * 256 + ai * 128 + m * 16 + lrow_;
                GAS bf16_t* rp = (GAS bf16_t*)HE + (size_t)row * DEXP + j * 128 + lcol_;
                const float rs = ((const GAS float*)rss)[row];
                f32x4 h[2];
#pragma unroll
                for (int bj = 0; bj < 2; ++bj) {
                    const f32x4 g = acc[ai][bj][m][0] * rs, up = acc[ai][bj][m][1] * rs;
#pragma unroll
                    for (int i = 0; i < 4; ++i) h[bj][i] = g[i] * __builtin_amdgcn_rcpf(1.f + __expf(-g[i])) * up[i];
                }
                *(GAS u32x4*)rp = pack8(h[0], h[1]);
            }
    }
};
struct Down {
    static constexpr bool PERM = true, WIDE = true, AFTER_DRAIN = false;
    bf16_t* Y; const int* src; const float* wgt;
    __device__ __forceinline__ void operator()(const f32x4 (&acc)[2][2][4][2], const Unit& u, int wr, int wc, int fr, int fq) const {
        int pm_ = u.pm, pn_ = u.pn, lrow_ = wr * 64 + fr, lcol_ = wc * 64 + 16 * fq;
        asm volatile("" : "+s"(pm_), "+s"(pn_), "+v"(lrow_), "+v"(lcol_));
        const int j = pn_ & 3;
        int sv[8]; float wv[8];
#pragma unroll
        for (int i = 0; i < 8; ++i) { const int row = pm_ * 256 + (i >> 2) * 128 + (i & 3) * 16 + lrow_; sv[i] = ((const GAS int*)src)[row]; wv[i] = ((const GAS float*)wgt)[row]; }
#pragma unroll
        for (int ai = 0; ai < 2; ++ai)
#pragma unroll
            for (int m = 0; m < 4; ++m) {
                const int s = sv[ai * 4 + m];
                if (s >= 0) {
                    const float w = wv[ai * 4 + m];
                    GAS bf16_t* rp = (GAS bf16_t*)Y + ((size_t)(s & 1) * T + (s >> 1)) * DM + j * 256 + lcol_;
#pragma unroll
                    for (int bj = 0; bj < 2; ++bj) *(GAS u32x4*)(rp + bj * 8) = pack8(acc[ai][bj][m][0] * w, acc[ai][bj][m][1] * w);
                }
            }
    }
};
}

namespace att {
constexpr int KROW = 112, VROW = 192, KT = 64 * KROW, VT = 64 * VROW, BUF = KT + VT;
typedef int v8i32_t __attribute__((ext_vector_type(8)));
typedef int v4i32_t __attribute__((ext_vector_type(4)));
#define MFMA8(a, b, c) __builtin_amdgcn_mfma_scale_f32_32x32x64_f8f6f4(a, b, c, 0, 0, 0, 0x7F7F7F7F, 0, 0x7B7B7B7B)
constexpr int LDS_WS = 2 * BUF, LDS_BYTES = LDS_WS + 8 * 256;
constexpr float THR_L2 = 8.f * 1.4426950408889634f;
__device__ __forceinline__ void partialSM(f32x16& p0, f32x16& p1, float& m_reg, float& mn, float& alpha) {
    float pmax = p0[0];
#pragma unroll
    for (int r = 1; r < 16; ++r) pmax = fmaxf(pmax, p0[r]);
#pragma unroll
    for (int r = 0; r < 16; ++r) pmax = fmaxf(pmax, p1[r]);
    { auto rr = __builtin_amdgcn_permlane32_swap(__float_as_uint(pmax), __float_as_uint(pmax), false, false);
      pmax = fmaxf(__uint_as_float(rr[0]), __uint_as_float(rr[1])); }
    if (__builtin_expect(__all(pmax - m_reg <= THR_L2), 1)) { mn = m_reg; alpha = 1.f; }
    else { mn = fmaxf(m_reg, pmax); alpha = __builtin_amdgcn_exp2f(m_reg - mn); m_reg = mn; }
#pragma unroll
    for (int r = 0; r < 16; ++r) p0[r] = p0[r] - mn;
#pragma unroll
    for (int r = 0; r < 16; ++r) p1[r] = p1[r] - mn;
#pragma unroll
    for (int r = 0; r < 16; ++r) p0[r] = __builtin_amdgcn_exp2f(p0[r]);
}
__device__ __forceinline__ void finishSM(f32x16& p0, f32x16& p1, float alpha, float& l_reg, bf16x8& pa0, bf16x8& pa1, bf16x8& pa2, bf16x8& pa3) {
#pragma unroll
    for (int r = 0; r < 16; ++r) p1[r] = __builtin_amdgcn_exp2f(p1[r]);
    float ps = 0;
#pragma unroll
    for (int r = 0; r < 16; ++r) ps += p0[r];
#pragma unroll
    for (int r = 0; r < 16; ++r) ps += p1[r];
    { auto rr = __builtin_amdgcn_permlane32_swap(__float_as_uint(ps), __float_as_uint(ps), false, false);
      ps = __uint_as_float(rr[0]) + __uint_as_float(rr[1]); }
    l_reg = l_reg * alpha + ps;
    PK4(p0, 0, pa0); PK4(p0, 8, pa1); PK4(p1, 0, pa2); PK4(p1, 8, pa3);
}
__device__ __forceinline__ void qkt(f32x16& p0, f32x16& p1, const LAS unsigned char* Ks, const v8i32_t* q8, int r32, int hi) {
    const v8i32_t a0 = *(const LAS v8i32_t*)(Ks + r32 * KROW + 32 * hi), a1 = *(const LAS v8i32_t*)(Ks + (32 + r32) * KROW + 32 * hi);
    const v8i32_t c0 = *(const LAS v8i32_t*)(Ks + r32 * KROW + 64), c1 = *(const LAS v8i32_t*)(Ks + (32 + r32) * KROW + 64);
    p0 = MFMA8(a0, q8[0], (f32x16){}); p1 = MFMA8(a1, q8[0], (f32x16){});
    p0 = MFMA8(c0, q8[1], p0); p1 = MFMA8(c1, q8[1], p1);
}
__device__ __forceinline__ void load_q8(v8i32_t* q8, const unsigned char* Qrow, int hi) {
    const v4i32_t x0 = *(const GAS v4i32_t*)((const GAS unsigned char*)Qrow + 32 * hi), x1 = *(const GAS v4i32_t*)((const GAS unsigned char*)Qrow + 32 * hi + 16);
    v4i32_t y0 = *(const GAS v4i32_t*)((const GAS unsigned char*)Qrow + 64), y1 = *(const GAS v4i32_t*)((const GAS unsigned char*)Qrow + 80);
    if (hi) { y0 = (v4i32_t){0, 0, 0, 0}; y1 = (v4i32_t){0, 0, 0, 0}; }
    q8[0] = __builtin_shufflevector(x0, x1, 0, 1, 2, 3, 4, 5, 6, 7); q8[1] = __builtin_shufflevector(y0, y1, 0, 1, 2, 3, 4, 5, 6, 7);
}
__device__ __forceinline__ void pv(f32x16* o, const LAS unsigned char* vb, bf16x8 pa0, bf16x8 pa1, bf16x8 pa2, bf16x8 pa3) {
#pragma unroll
    for (int d0 = 0; d0 < 2; ++d0) {
        const bf16x8 v0 = tr_frag(vb + 0 * 16 * VROW + d0 * 64, VROW), v1 = tr_frag(vb + 1 * 16 * VROW + d0 * 64, VROW);
        const bf16x8 v2 = tr_frag(vb + 2 * 16 * VROW + d0 * 64, VROW), v3 = tr_frag(vb + 3 * 16 * VROW + d0 * 64, VROW);
        o[d0] = __builtin_amdgcn_mfma_f32_32x32x16_bf16(pa0, v0, o[d0], 0, 0, 0);
        o[d0] = __builtin_amdgcn_mfma_f32_32x32x16_bf16(pa1, v1, o[d0], 0, 0, 0);
        o[d0] = __builtin_amdgcn_mfma_f32_32x32x16_bf16(pa2, v2, o[d0], 0, 0, 0);
        o[d0] = __builtin_amdgcn_mfma_f32_32x32x16_bf16(pa3, v3, o[d0], 0, 0, 0);
    }
}
struct Stage8 {
    const GAS unsigned char* vsrc; const GAS unsigned char* ksrc; unsigned kstride; int vdst, kdst; bool has_k;
    __device__ __forceinline__ void init(const unsigned char* V8g, const unsigned char* K8g, const unsigned char* KR8g, int b, int h, int tid) {
        const int sr = tid >> 3, sc = (tid & 7) * 8;
        vsrc = (const GAS unsigned char*)V8g + ((size_t)(b * SEQ + sr) * 8 + h) * 64 + sc; vdst = KT + sr * VROW + sc * 2;
        has_k = tid < 384;
        if (tid < 256) { const int key = tid >> 2, c = tid & 3; ksrc = (const GAS unsigned char*)K8g + ((size_t)(b * SEQ + key) * 8 + h) * 64 + c * 16; kstride = 64 * 512; kdst = key * KROW + c * 16; }
        else { const int t2 = (tid - 256) & 127, key = t2 >> 1, c = t2 & 1; ksrc = (const GAS unsigned char*)KR8g + (size_t)(b * SEQ + key) * 32 + c * 16; kstride = 64 * 32; kdst = key * KROW + 64 + c * 16; }
    }
};
struct StageRegs { u32x4 v, k; };
__device__ __forceinline__ u32x4 fp8x8_to_bf16(unsigned a, unsigned b) {
    const f32x2 a0 = __builtin_amdgcn_cvt_pk_f32_fp8((int)a, false), a1 = __builtin_amdgcn_cvt_pk_f32_fp8((int)a, true), b0 = __builtin_amdgcn_cvt_pk_f32_fp8((int)b, false), b1 = __builtin_amdgcn_cvt_pk_f32_fp8((int)b, true);
    u32x4 w; w.x = pk2(a0[0], a0[1]); w.y = pk2(a1[0], a1[1]); w.z = pk2(b0[0], b0[1]); w.w = pk2(b1[0], b1[1]); return w; }
#define S8_LOAD(R, S, tile) do { { const u32x2 v8_ = *(const GAS u32x2*)((S).vsrc + (size_t)(tile) * (64 * 512)); (R).v.x = v8_.x; (R).v.y = v8_.y; } (R).k = *(const GAS u32x4*)((S).ksrc + (size_t)(tile) * (S).kstride); } while (0)
#define S8_WRITE(lds_, bo, R, S) do { *(LAS u32x4*)((lds_) + (bo) + (S).vdst) = fp8x8_to_bf16((R).v.x, (R).v.y); if ((S).has_k) *(LAS u32x4*)((lds_) + (bo) + (S).kdst) = (R).k; } while (0)

__device__ __forceinline__ void attn_unit(const unsigned char* Q8g, const unsigned char* KVg, const unsigned char* K8g, const unsigned char* KR8g, bf16_t* CATg, int b, int h, int qb, LAS unsigned char* lds) {
    const int tid = ltid(), wid = tid >> 6, lane = tid & 63, r32 = lane & 31, hi = lane >> 5;
    LAS float* wsf = (LAS float*)(lds + LDS_WS) + wid * 64; LAS float* li_l = wsf; LAS float* al_l = wsf + 32;
    float m_reg = -1e30f, l_reg = 0; f32x16 o[2] = {}; v8i32_t q8[2];
    load_q8(q8, Q8g + (size_t)(b * SEQ + qb * 256 + wid * 32 + r32) * QW + h * QKD, hi);
    Stage8 sg; sg.init(KVg, K8g, KR8g, b, h, tid);
    const LAS unsigned char* vb0 = lds + KT + tr_lane_off(lane, VROW);
    StageRegs st0, st1;
#define SWAIT() asm volatile("s_waitcnt vmcnt(2)" ::: "memory")
#define RESC(a) do { if (__any((a) < 1.f)) { if (hi == 0) al_l[r32] = (a); LDS_WAIT(); \
    _Pragma("unroll") for (int d = 0; d < 2; ++d) _Pragma("unroll") for (int r = 0; r < 16; ++r) o[d][r] *= al_l[crow(r, hi)]; } } while (0)
    f32x16 pA0, pA1, pB0, pB1; float mnA, mnB, alA, alB; bf16x8 pa0, pa1, pa2, pa3; constexpr int NT = SEQ / 64;
    __syncthreads();
    S8_LOAD(st0, sg, 0); VM_WAIT(); S8_WRITE(lds, 0, st0, sg); __syncthreads();
    qkt(pA0, pA1, lds, q8, r32, hi); partialSM(pA0, pA1, m_reg, mnA, alA);
    S8_LOAD(st1, sg, 1); S8_LOAD(st0, sg, 2);
    SWAIT(); S8_WRITE(lds, BUF, st1, sg); __syncthreads();
    for (int j = 1; j + 1 < NT; j += 2) {
        SBAR(); qkt(pB0, pB1, lds + BUF, q8, r32, hi);
        finishSM(pA0, pA1, alA, l_reg, pa0, pa1, pa2, pa3); SBAR();
        S8_LOAD(st1, sg, j + 2); SBAR();
        pv(o, vb0, pa0, pa1, pa2, pa3); partialSM(pB0, pB1, m_reg, mnB, alB);
        __syncthreads(); SWAIT(); S8_WRITE(lds, 0, st0, sg);
        RESC(alB); __syncthreads();
        SBAR(); qkt(pA0, pA1, lds, q8, r32, hi);
        finishSM(pB0, pB1, alB, l_reg, pa0, pa1, pa2, pa3); SBAR();
        if (j + 3 < NT) S8_LOAD(st0, sg, j + 3); SBAR();
        pv(o, vb0 + BUF, pa0, pa1, pa2, pa3); partialSM(pA0, pA1, m_reg, mnA, alA);
        __syncthreads(); SWAIT(); S8_WRITE(lds, BUF, st1, sg);
        RESC(alA); __syncthreads();
    }
    SBAR(); qkt(pB0, pB1, lds + BUF, q8, r32, hi);
    finishSM(pA0, pA1, alA, l_reg, pa0, pa1, pa2, pa3); SBAR();
    pv(o, vb0, pa0, pa1, pa2, pa3); partialSM(pB0, pB1, m_reg, mnB, alB);
    __syncthreads(); RESC(alB);
    finishSM(pB0, pB1, alB, l_reg, pa0, pa1, pa2, pa3); SBAR();
    pv(o, vb0 + BUF, pa0, pa1, pa2, pa3);
    if (hi == 0) li_l[r32] = l_reg; LDS_WAIT();
    GAS bf16_t* Ow = (GAS bf16_t*)CATg + (size_t)(b * SEQ + qb * 256 + wid * 32) * DM + 512 + h * 64 + r32;
#pragma unroll
    for (int r = 0; r < 16; ++r) { const int orow = crow(r, hi); const float rl = __builtin_amdgcn_rcpf(li_l[orow]);
#pragma unroll
        for (int d0 = 0; d0 < 2; ++d0) Ow[(size_t)orow * DM + d0 * 32] = (bf16_t)f2bf(o[d0][r] * rl); }
#undef SWAIT
#undef RESC
}
__device__ __forceinline__ int tr_lane_off2(int lane, int stride) { const int i = lane & 15; return ((lane >> 5) * 4 + (i >> 2)) * stride + (((lane >> 4) & 1) * 16 + (i & 3) * 4) * 2; }
__device__ __forceinline__ bf16x8 tr_frag2(const LAS unsigned char* p, int stride) { const s16x4 a = vtr(p), b = vtr(p + 8 * stride); return (bf16x8){a[0], a[1], a[2], a[3], b[0], b[1], b[2], b[3]}; }
constexpr int LDS_WS3 = 3 * BUF;
typedef float f32x2_t __attribute__((ext_vector_type(2)));
typedef __bf16 bf16x2_t __attribute__((ext_vector_type(2)));
__device__ __forceinline__ unsigned cvtpk_s(float lo, float hi) { f32x2_t v = {lo, hi}; bf16x2_t r = __builtin_convertvector(v, bf16x2_t); return __builtin_bit_cast(unsigned, r); }
#ifndef ATT_SGB
#define ATT_SGB 1
#endif
#define SGB(mask, n) do { if (ATT_SGB) __builtin_amdgcn_sched_group_barrier(mask, n, 0); } while (0)
__device__ __forceinline__ int vt_pos(int k) { return 32 * ((k >> 2) & 1) + (k & 3) + 4 * ((k & 31) >> 3) + 16 * (k >> 5); }
constexpr int VTROW = 80, VT8 = 64 * VTROW, BUF8 = KT + VT8;
constexpr int LDS_WSF = 8 * BUF8;
#define MFMA8F(a, b, c) __builtin_amdgcn_mfma_scale_f32_32x32x64_f8f6f4(a, b, c, 0, 0, 0, 0x7F7F7F7F, 0, 0x7D7D7D7D)
#define MFMA16S(a, b, c) __builtin_amdgcn_mfma_scale_f32_16x16x128_f8f6f4(a, b, c, 1  , 0  , 0, 0x7F7F7F7F, 0, 0x7F7F7F7F)
#define MFMA8PV(a, b, c) __builtin_amdgcn_mfma_scale_f32_32x32x64_f8f6f4(a, b, c, 1  , 0  , 0, 0x7F7F7F7F, 0, 0x7F7F7F7F)
__device__ __forceinline__ void vt_block(LAS unsigned char* blk, const unsigned char* V8g, unsigned char* V8T, int b, int h, int tile, int lane) {
    const int pos = vt_pos(lane);
    const GAS unsigned char* src = (const GAS unsigned char*)V8g + ((size_t)(b * SEQ + tile * 64 + lane) * 8 + h) * 64;
#pragma unroll
    for (int c16 = 0; c16 < 4; ++c16) { const u32x4 w = *(const GAS u32x4*)(src + c16 * 16);
#pragma unroll
        for (int k = 0; k < 4; ++k) { const unsigned d = w[k]; LAS unsigned char* p = blk + (c16 * 16 + k * 4) * 64 + pos;
            p[0] = (unsigned char)d; p[64] = (unsigned char)(d >> 8); p[128] = (unsigned char)(d >> 16); p[192] = (unsigned char)(d >> 24); } }
    LDS_WAIT(); asm volatile("" ::: "memory");
    GAS unsigned char* dst = (GAS unsigned char*)V8T + (size_t)((b * NH + h) * (SEQ / 64) + tile) * 4096;
#pragma unroll
    for (int k = 0; k < 4; ++k) *(GAS u32x4*)(dst + (lane + 64 * k) * 16) = *(const LAS u32x4*)(blk + (lane + 64 * k) * 16);
    LDS_WAIT(); asm volatile("" ::: "memory");
}
__device__ __forceinline__ void vt_phase(LAS unsigned char* lds, const unsigned char* V8g, unsigned char* V8T) {
    const int tid = ltid(), wid = tid >> 6, lane = tid & 63;
    const int gw = lbid() * 8 + wid, NGW = gridDim.x * 8;
    for (int u = gw; u < BATCH * NH * (SEQ / 64); u += NGW) { const int tile = u & 255, bh = u >> 8; vt_block(lds + wid * 4096, V8g, V8T, bh >> 3, bh & 7, tile, lane); }
}
struct StageF {
    const GAS unsigned char* asrc; unsigned astride; int adst; const GAS unsigned char* rsrc; int rdst; bool has_r; const GAS unsigned char* rsrc2; int rdst2;
    __device__ __forceinline__ void init(const unsigned char* K8g, const unsigned char* KR8g, const unsigned char* V8Tg, int b, int h, int tid) {
        if (tid < 256) { const int key = tid >> 2, c = tid & 3; asrc = (const GAS unsigned char*)K8g + ((size_t)(b * SEQ + key) * 8 + h) * 64 + c * 16; astride = 64 * 512; adst = key * KROW + c * 16; }
        else { const int c = tid - 256, col = c >> 2, part = c & 3; asrc = (const GAS unsigned char*)V8Tg + (size_t)((b * NH + h) * (SEQ / 64)) * 4096 + c * 16; astride = 4096; adst = KT + col * VTROW + part * 16; }
        has_r = tid < 128; { const int t2 = tid & 127, key = t2 >> 1, c = t2 & 1; rsrc = (const GAS unsigned char*)KR8g + (size_t)(b * SEQ + key) * 32 + c * 16; rdst = key * KROW + 64 + c * 16; }
        { const int q4 = tid >> 7, t2 = tid & 127, key = t2 >> 1, c = t2 & 1; rsrc2 = (const GAS unsigned char*)KR8g + (size_t)(b * SEQ + key) * 32 + c * 16 + q4 * 2048; rdst2 = q4 * BUF8 + key * KROW + 64 + c * 16; }
    }
};
struct StageFRegs { u32x4 a, r; };
#define SF_LOAD(R, S, tile) do { (R).a = *(const GAS u32x4*)((S).asrc + (size_t)(tile) * (S).astride); (R).r = *(const GAS u32x4*)((S).rsrc + (size_t)(tile) * 2048); } while (0)
#define SF_LOAD_E(R, S, tile) do { (R).a = *(const GAS u32x4*)((S).asrc + (size_t)(tile) * (S).astride); (R).r = *(const GAS u32x4*)((S).rsrc2 + (size_t)(tile) * 2048); } while (0)
#define SF_LOAD_O(R, S, tile) do { (R).a = *(const GAS u32x4*)((S).asrc + (size_t)(tile) * (S).astride); } while (0)
#define SF_WRITE_E(lds_, bo, R, S) do { *(LAS u32x4*)((lds_) + (bo) + (S).adst) = (R).a; *(LAS u32x4*)((lds_) + (bo) + (S).rdst2) = (R).r; } while (0)
#define SF_WRITE_O(lds_, bo, R, S) do { *(LAS u32x4*)((lds_) + (bo) + (S).adst) = (R).a; } while (0)
#define SF_WRITE(lds_, bo, R, S) do { *(LAS u32x4*)((lds_) + (bo) + (S).adst) = (R).a; *(LAS u32x4*)((lds_) + (bo) + (S).rdst) = (R).r; } while (0)
__device__ __forceinline__ int pk4_q(float a, float b, float c, float d) { unsigned w = __builtin_bit_cast(unsigned, a);
    w = __builtin_amdgcn_cvt_pk_u8_f32(a, 0, w); w = __builtin_amdgcn_cvt_pk_u8_f32(b, 1, w); w = __builtin_amdgcn_cvt_pk_u8_f32(c, 2, w); w = __builtin_amdgcn_cvt_pk_u8_f32(d, 3, w); return (int)w; }
#ifndef ATT_QPAD
#define ATT_QPAD 0xB653
#endif
template <int PM> __device__ __forceinline__ bool attn_unit_fast(const unsigned char* Q8g, const unsigned char* K8g, const unsigned char* KR8g, const unsigned char* V8Tg, bf16_t* CATg, int b, int h, int qb, LAS unsigned char* lds) {
    const int tid = ltid(), wid = tid >> 6, lane = tid & 63, r32 = lane & 31, hi = lane >> 5;
    f32x16 o0 = {}, o1 = {}; f32x4 o2 = {}; v8i32_t q8[2];
    int onesw = 0x38383838, zw = 0; asm volatile("" : "+v"(onesw), "+v"(zw));
    { const bool on = (((lane >> 4) & 1) == 0) == ((lane & 15) < 8); onesw = on ? onesw : zw; }
    const v8i32_t ones = {onesw, onesw, onesw, onesw, onesw, onesw, onesw, onesw};
    load_q8(q8, Q8g + (size_t)(b * SEQ + qb * 256 + wid * 32 + r32) * QW + h * QKD, hi);
    StageF sg; sg.init(K8g, KR8g, V8Tg, b, h, tid);
    const LAS unsigned char* kl = lds + r32 * KROW;
    const LAS unsigned char* vl = lds + KT + r32 * VTROW + 32 * hi;
    StageFRegs st0, st1;
    f32x16 pA0, pA1, pB0, pB1; constexpr int NT = SEQ / 64;
    if (hi) { q8[1] = (v8i32_t){0, 0, 0, 0, ATT_QPAD, 0, 0, 0}; }
    __syncthreads();
    if (tid == 0) *(LAS unsigned*)(lds + LDS_WSF + 2048) = 0u;
    *(LAS u32x4*)(lds + (tid >> 6) * BUF8 + (tid & 63) * KROW + 96) = (u32x4){(unsigned)zw + 0x3858u, (unsigned)zw, (unsigned)zw, (unsigned)zw};
    SF_LOAD(st0, sg, 0); SF_LOAD(st1, sg, 1); VM_WAIT(); SF_WRITE(lds, 0, st0, sg); SF_WRITE(lds, BUF8, st1, sg);
    SF_LOAD(st0, sg, 2); SF_LOAD(st1, sg, 3); VM_WAIT(); SF_WRITE(lds, 2 * BUF8, st0, sg); SF_WRITE(lds, 3 * BUF8, st1, sg); SF_LOAD_E(st0, sg, 4); SF_LOAD_O(st1, sg, 5);
    __syncthreads();
    {
        const v8i32_t a0 = *(const LAS v8i32_t*)(kl + 32 * hi), a1 = *(const LAS v8i32_t*)(kl + 32 * KROW + 32 * hi), c0 = *(const LAS v8i32_t*)(kl + 64 + 16 * hi), c1 = *(const LAS v8i32_t*)(kl + 32 * KROW + 64 + 16 * hi);
        pA0 = MFMA8F(a0, q8[0], (f32x16){}); pA1 = MFMA8F(a1, q8[0], (f32x16){}); pA0 = MFMA8F(c0, q8[1], pA0); pA1 = MFMA8F(c1, q8[1], pA1);
    }
    v8i32_t pap = {0, 0, 0, 0, 0, 0, 0, 0};
#define ATT_ITER(X0, X1, Y0, Y1, ST, HAS_NEXT, DO_WRITE, MODE, JLOAD, BARRIER) do { \
        const LAS unsigned char* kp = kl + o_nxt; const LAS unsigned char* vp = vl + o_prv; \
        const v8i32_t ka0 = *(const LAS v8i32_t*)(kp + 32 * hi), kb0 = *(const LAS v8i32_t*)(kp + 32 * KROW + 32 * hi); \
        const v8i32_t va = *(const LAS v8i32_t*)(vp), vb = *(const LAS v8i32_t*)(vp + 32 * VTROW); \
        const v8i32_t ka1 = *(const LAS v8i32_t*)(kp + 64 + 16 * hi), kb1 = *(const LAS v8i32_t*)(kp + 32 * KROW + 64 + 16 * hi); \
        SBAR(); \
        if (HAS_NEXT) { Y0 = MFMA8F(ka0, q8[0], (f32x16){}); Y1 = MFMA8F(kb0, q8[0], (f32x16){}); } \
        o0 = MFMA8PV(pap, va, o0); o1 = MFMA8PV(pap, vb, o1); \
        if (HAS_NEXT) { Y0 = MFMA8F(ka1, q8[1], Y0); Y1 = MFMA8F(kb1, q8[1], Y1); } \
        o2 = MFMA16S(pap, ones, o2); \
        v8i32_t pan; \
        pan[0] = pk4_q(X0[0], X0[1], X0[2], X0[3]); pan[1] = pk4_q(X0[4], X0[5], X0[6], X0[7]); pan[2] = pk4_q(X0[8], X0[9], X0[10], X0[11]); pan[3] = pk4_q(X0[12], X0[13], X0[14], X0[15]); \
        pan[4] = pk4_q(X1[0], X1[1], X1[2], X1[3]); pan[5] = pk4_q(X1[4], X1[5], X1[6], X1[7]); pan[6] = pk4_q(X1[8], X1[9], X1[10], X1[11]); pan[7] = pk4_q(X1[12], X1[13], X1[14], X1[15]); \
        SGB(0x8, 1); SGB(0x2, 5); SGB(0x8, 1); SGB(0x2, 5); SGB(0x8, 1); SGB(0x2, 5); SGB(0x8, 1); SGB(0x2, 5); \
        SGB(0x8, 1); SGB(0x2, 4); SGB(0x8, 1); SGB(0x2, 4); SGB(0x8, 1); SGB(0x2, 4); \
        SBAR(); \
        pap = pan; \
        if (DO_WRITE) { if ((MODE) == 1) { SF_WRITE_E(lds, o_wr, ST, sg); SF_LOAD_O(ST, sg, JLOAD); } else if ((MODE) == 2) { SF_WRITE_O(lds, o_wr, ST, sg); SF_LOAD_E(ST, sg, JLOAD); } else { SF_WRITE_O(lds, o_wr, ST, sg); SF_LOAD_O(ST, sg, JLOAD); } }         \
        if ((BARRIER) && !(PM & 4)) __syncthreads(); } while (0)
#define OFF8(C8, k) ((((C8) + (k)) & 7) * BUF8)
#define CLAMP(t) ((t) < NT ? (t) : NT - 1)
#define ATT_POS(C8, p, PRV, XA0, XA1, XB0, XB1, ST, HAS_NEXT, DO_WRITE, MODE, JLOAD, NN, BARRIER) { constexpr int o_prv = OFF8(C8, PRV), o_nxt = OFF8(C8, (p) + 1), o_wr = OFF8(C8, (p) + 4); (void)o_wr; (void)(NN); ATT_ITER(XA0, XA1, XB0, XB1, ST, HAS_NEXT, DO_WRITE, MODE, JLOAD, BARRIER); }
#define ATT_QUAD(C8, j) \
        ATT_POS(C8, 0, 7, pA0, pA1, pB0, pB1, st0, true, true, 1, CLAMP((j) + 6), 2, false) \
        ATT_POS(C8, 1, 0, pB0, pB1, pA0, pA1, st1, true, true, 0, CLAMP((j) + 7), 3, true) \
        ATT_POS(C8, 2, 1, pA0, pA1, pB0, pB1, st0, true, true, 2, CLAMP((j) + 8), 4, false) \
        ATT_POS(C8, 3, 2, pB0, pB1, pA0, pA1, st1, true, true, 0, CLAMP((j) + 9), 5, true)
    {
        ATT_POS(0, 0, 0, pA0, pA1, pB0, pB1, st0, true, true, 1, 6, 2, false)
        ATT_POS(0, 1, 0, pB0, pB1, pA0, pA1, st1, true, true, 0, 7, 3, true)
        ATT_POS(0, 2, 1, pA0, pA1, pB0, pB1, st0, true, true, 2, 8, 4, false)
        ATT_POS(0, 3, 2, pB0, pB1, pA0, pA1, st1, true, true, 0, 9, 5, true)
    }
    static_assert((NT - 8) % 8 == 0, "main loop: two quads per trip");
    for (int j = 4; j < NT - 4; j += 8) {
        ATT_QUAD(4, j)
        ATT_QUAD(0, j + 4)
    }
    {
        ATT_POS(4, 0, 7, pA0, pA1, pB0, pB1, st0, true, false, 0, 0, 2, false)
        ATT_POS(4, 1, 0, pB0, pB1, pA0, pA1, st0, true, false, 0, 0, 3, true)
        ATT_POS(4, 2, 1, pA0, pA1, pB0, pB1, st0, true, false, 0, 0, 1, false)
        ATT_POS(4, 3, 2, pB0, pB1, pA0, pA1, st0, false, false, 0, 0, 1, true)
    }
#undef ATT_QUAD
#undef ATT_POS
#undef CLAMP
    {
        const LAS unsigned char* vp = vl + ((NT - 1) & 7) * BUF8;
        const v8i32_t va = *(const LAS v8i32_t*)(vp), vb = *(const LAS v8i32_t*)(vp + 32 * VTROW);
        o0 = MFMA8PV(pap, va, o0); o1 = MFMA8PV(pap, vb, o1); o2 = MFMA16S(pap, ones, o2);
    }
#undef OFF8
    LAS float* lsum = (LAS float*)(lds + LDS_WSF + 2304) + wid * 32;
    if ((lane & 7) == 0) {
#pragma unroll
        for (int i = 0; i < 4; ++i) lsum[((lane & 8) ? 16 : 0) + 4 * (lane >> 4) + i] = o2[i]; }
    LDS_WAIT(); asm volatile("" ::: "memory");
    float rs[16];
#pragma unroll
    for (int r = 0; r < 16; ++r) rs[r] = lsum[crow(r, hi)];
    float fin = 0.f; bool lbad = false;
#pragma unroll
    for (int r = 0; r < 16; ++r) { fin += fabsf(o0[r]) + fabsf(o1[r]); lbad |= !(rs[r] > 0.f) || !(rs[r] < 57000.f); }
    const bool bad = !(fin < 3.0e38f) || lbad;
    GAS bf16_t* Ow = (GAS bf16_t*)CATg + (size_t)(b * SEQ + qb * 256 + wid * 32) * DM + 512 + h * 64 + r32;
#pragma unroll
    for (int r = 0; r < 16; ++r) { const int orow = crow(r, hi); const float rl = __builtin_amdgcn_rcpf(rs[r]);
        Ow[(size_t)orow * DM] = (bf16_t)f2bf(o0[r] * rl); Ow[(size_t)orow * DM + 32] = (bf16_t)f2bf(o1[r] * rl); }
#undef ATT_ITER
    LAS unsigned* flag = (LAS unsigned*)(lds + LDS_WSF + 2048);
    if (bad) *flag = 1u;
    __syncthreads();
    const bool redo = (*flag != 0u);
    __syncthreads();
    return redo;
}
#ifndef ATT_FORCE_EXACT
#define ATT_FORCE_EXACT 0
#endif
template <int PM> __device__ __forceinline__ void attn_phase(const unsigned char* Qg, const unsigned char* KVg, const unsigned char* K8g, const unsigned char* KRg, const unsigned char* V8Tg, bf16_t* CATg, LAS unsigned char* lds) {
    const int G = gridDim.x, bid = lbid();
    constexpr int NU = BATCH * NH * (SEQ / 256);
    if (G == 256) {
        const int xcd = bid & 7, j = bid >> 3;
        for (int i = 0; i < 4; ++i) { const int bh = 2 * xcd + (i >> 1), qb = j + 32 * (i & 1); if ((attn_unit_fast<PM>(Qg, K8g, KRg, V8Tg, CATg, bh >> 3, bh & 7, qb, lds) || ATT_FORCE_EXACT) && PM == 0) attn_unit(Qg, KVg, K8g, KRg, CATg, bh >> 3, bh & 7, qb, lds); }
    } else {
        for (int u = bid; u < NU; u += G) { const int bh = u >> 6, qb = u & 63; if ((attn_unit_fast<PM>(Qg, K8g, KRg, V8Tg, CATg, bh >> 3, bh & 7, qb, lds) || ATT_FORCE_EXACT) && PM == 0) attn_unit(Qg, KVg, K8g, KRg, CATg, bh >> 3, bh & 7, qb, lds); }
    }
}
}

namespace gla {
constexpr int L_WA = 0, L_BA = 16384, L_A = 17408, L_LA = 25600, L_T0 = 58368;
constexpr int QROW = 272, L_QD = L_T0, L_KI = L_T0 + 64 * QROW;
constexpr int KEROW = 320, L_KE = L_T0;
constexpr int VROW = 576, L_V = 93184, L_NG = L_V + 64 * VROW, L_END = L_NG + 256;
constexpr int OSROW = 260;
static_assert(L_KI + 64 * QROW <= L_V && L_LA + 64 * OSROW * 4 <= L_V && L_END <= 131072, "gla lds map");

__device__ __forceinline__ void load_consts(LAS unsigned char* lds, const float* waf, const float* baf, const float* wab, const float* bab, const float* ng) {
    const int tid = ltid();
    LAS float* wa = (LAS float*)(lds + L_WA); LAS float* ba = (LAS float*)(lds + L_BA);
    for (int i = tid; i < 2048; i += 512) { wa[i] = ((const GAS float*)waf)[i]; wa[2048 + i] = ((const GAS float*)wab)[i]; }
    if (tid < 128) { ba[tid] = ((const GAS float*)baf)[tid]; ba[128 + tid] = ((const GAS float*)bab)[tid]; }
    if (tid < 64) ((LAS float*)(lds + L_NG))[tid] = ((const GAS float*)ng)[tid];
}
constexpr int L_TOT = 131072 + 1024;
__device__ __forceinline__ void compute_la(LAS unsigned char* lds, int dir) {
    const int tid = ltid(), c = tid & 127, seg = tid >> 7;
    const LAS float* wa = (const LAS float*)(lds + L_WA) + dir * 2048; const LAS float* a = (const LAS float*)(lds + L_A) + dir * 16 + seg * 16 * 32;
    LAS float* la = (LAS float*)(lds + L_LA) + seg * 16 * 128 + c; LAS float* tot = (LAS float*)(lds + L_TOT);
    float w[16], v[16];
#pragma unroll
    for (int r = 0; r < 16; ++r) w[r] = wa[r * 128 + c];
    const float bias = ((const LAS float*)(lds + L_BA))[dir * 128 + c];
#pragma unroll
    for (int k = 0; k < 16; ++k) { float s = bias;
#pragma unroll
        for (int q = 0; q < 4; ++q) { const f32x4 av = *(const LAS f32x4*)(a + k * 32 + 4 * q);
            s = fmaf(av[0], w[4 * q], s); s = fmaf(av[1], w[4 * q + 1], s); s = fmaf(av[2], w[4 * q + 2], s); s = fmaf(av[3], w[4 * q + 3], s); }
        const float e = __builtin_amdgcn_exp2f(fabsf(s) * -1.4426950408889634f);
        v[k] = (fminf(s, 0.f) - 0.6931471805599453f * __builtin_amdgcn_logf(1.f + e)) * (1.f / 16.f); }
    if (dir == 0) {
#pragma unroll
        for (int k = 1; k < 16; ++k) v[k] += v[k - 1];
        tot[seg * 128 + c] = v[15];
    } else {
#pragma unroll
        for (int k = 14; k >= 0; --k) v[k] += v[k + 1];
        tot[seg * 128 + c] = v[0];
    }
    __syncthreads();
    float off = 0.f;
#pragma unroll
    for (int q = 0; q < 4; ++q) { const float tq = tot[q * 128 + c]; off += ((dir == 0) ? (q < seg) : (q > seg)) ? tq : 0.f; }
#pragma unroll
    for (int k = 0; k < 16; ++k) la[k * 128] = v[k] + off;
}
__device__ __forceinline__ void g1_unit(LAS unsigned char* lds, const bf16_t* P, bf16_t* S, float* DEC, int cidx, const float* ROPE, float* RSQ, float* RSKV, unsigned char* KR) {
    const int tid = ltid(), wid = tid >> 6, lane = tid & 63, r32 = lane & 31, hi = lane >> 5;
    const int b = cidx >> 8, n = cidx & 255, token0 = cidx * 64;
    __syncthreads();
    u32x4 vv[4], aw = {}, kw[2];
#pragma unroll
    for (int k = 0; k < 4; ++k) { const int id = tid + 512 * k, row = id >> 5, c = id & 31;
        vv[k] = *(const GAS u32x4*)((const GAS bf16_t*)P + (size_t)(token0 + row) * PW + PC_GV + c * 8); }
    if (tid < 256) aw = *(const GAS u32x4*)((const GAS bf16_t*)P + (size_t)(token0 + (tid >> 2)) * PW + PC_AF + (tid & 3) * 8);
#pragma unroll
    for (int k = 0; k < 2; ++k) { const int id = tid + 512 * k, row = id >> 4, c8 = (id & 15) * 8;
        kw[k] = *(const GAS u32x4*)((const GAS bf16_t*)P + (size_t)(token0 + row) * PW + PC_GK + c8); }
    const int token = token0 + (tid >> 3), sub = tid & 7;
    const GAS bf16_t* pr = (const GAS bf16_t*)P + (size_t)token * PW;
    u32x4 cq[4], ck[2];
#pragma unroll
    for (int k = 0; k < 4; ++k) cq[k] = *(const GAS u32x4*)(pr + PC_CQ + sub * 32 + k * 8);
#pragma unroll
    for (int k = 0; k < 2; ++k) ck[k] = *(const GAS u32x4*)(pr + PC_CKV + sub * 16 + k * 8);
    const unsigned w1 = *(const GAS unsigned*)(pr + PC_KR + 2 * sub), w2 = *(const GAS unsigned*)(pr + PC_KR + 16 + 2 * sub);
    const GAS float* rp = (const GAS float*)ROPE + (size_t)token * 32 + 2 * sub;
    const float c0 = rp[0], c1 = rp[1], s0 = rp[16], s1 = rp[17];
#pragma unroll
    for (int k = 0; k < 4; ++k) { const int id = tid + 512 * k, row = id >> 5, c = id & 31; *(LAS u32x4*)(lds + L_V + row * VROW + c * 16) = vv[k]; }
    if (tid < 256) { LAS float* a = (LAS float*)(lds + L_A) + (tid >> 2) * 32 + (tid & 3) * 8;
        a[0] = bflo(aw.x); a[1] = bfhi(aw.x); a[2] = bflo(aw.y); a[3] = bfhi(aw.y); a[4] = bflo(aw.z); a[5] = bfhi(aw.z); a[6] = bflo(aw.w); a[7] = bfhi(aw.w); }
    {   float sq = 0.f, skv = 0.f;
#pragma unroll
        for (int k = 0; k < 4; ++k) { const u32x4 w = cq[k];
            const float a0 = bflo(w.x), a1 = bfhi(w.x), a2 = bflo(w.y), a3 = bfhi(w.y), a4 = bflo(w.z), a5 = bfhi(w.z), a6 = bflo(w.w), a7 = bfhi(w.w);
            sq += (a0 * a0 + a1 * a1) + (a2 * a2 + a3 * a3) + (a4 * a4 + a5 * a5) + (a6 * a6 + a7 * a7); }
#pragma unroll
        for (int k = 0; k < 2; ++k) { const u32x4 w = ck[k];
            const float a0 = bflo(w.x), a1 = bfhi(w.x), a2 = bflo(w.y), a3 = bfhi(w.y), a4 = bflo(w.z), a5 = bfhi(w.z), a6 = bflo(w.w), a7 = bfhi(w.w);
            skv += (a0 * a0 + a1 * a1) + (a2 * a2 + a3 * a3) + (a4 * a4 + a5 * a5) + (a6 * a6 + a7 * a7); }
#pragma unroll
        for (int o = 1; o < 8; o <<= 1) { sq += shflx(sq, o); skv += shflx(skv, o); }
        if (sub == 0) { ((GAS float*)RSQ)[token] = rsqrtf(sq * (1.f / 256.f) + EPS); ((GAS float*)RSKV)[token] = rsqrtf(skv * (1.f / 128.f) + EPS); }
        const float x10 = bflo(w1), x11 = bfhi(w1), x20 = bflo(w2), x21 = bfhi(w2);
        *(GAS unsigned short*)((GAS unsigned char*)KR + (size_t)token * 32 + 2 * sub) = (unsigned short)__builtin_amdgcn_cvt_pk_fp8_f32(x10 * c0 - x20 * s0, x11 * c1 - x21 * s1, 0, false);
        *(GAS unsigned short*)((GAS unsigned char*)KR + (size_t)token * 32 + 16 + 2 * sub) = (unsigned short)__builtin_amdgcn_cvt_pk_fp8_f32(x10 * s0 + x20 * c0, x11 * s1 + x21 * c1, 0, false);
    }
    __syncthreads();
    for (int dir = 0; dir < 2; ++dir) {
        compute_la(lds, dir); __syncthreads();
        const LAS float* la = (const LAS float*)(lds + L_LA); const LAS float* bl = la + (dir ? 0 : 63) * 128;
#pragma unroll
        for (int k = 0; k < 2; ++k) { const int id = tid + 512 * k, row = id >> 4, c8 = (id & 15) * 8;
            const u32x4 w = kw[k];
            float kv[8] = {bflo(w.x), bfhi(w.x), bflo(w.y), bfhi(w.y), bflo(w.z), bfhi(w.z), bflo(w.w), bfhi(w.w)};
#pragma unroll
            for (int j = 0; j < 8; ++j) kv[j] *= __expf(bl[c8 + j] - la[row * 128 + c8 + j]);
            u32x4 o; o.x = pk2(kv[0], kv[1]); o.y = pk2(kv[2], kv[3]); o.z = pk2(kv[4], kv[5]); o.w = pk2(kv[6], kv[7]);
            *(LAS u32x4*)(lds + L_KE + row * KEROW + c8 * 2) = o; }
        const size_t sbase = (size_t)((dir * 2 + b) * NCHUNK + n);
        if (tid < 128) ((GAS float*)DEC)[sbase * 128 + tid] = __expf(bl[tid]);
        __syncthreads();
        { const int h = wid >> 1, vb = wid & 1;
          const LAS unsigned char* ab = lds + L_KE + tr_lane_off(lane, KEROW) + h * 64;
          const LAS unsigned char* bb = lds + L_V + tr_lane_off(lane, VROW) + (h * 64 + vb * 32) * 2;
          f32x16 acc = {};
#pragma unroll
          for (int ks = 0; ks < 4; ++ks) { const bf16x8 af = tr_frag(ab + ks * 16 * KEROW, KEROW), bf = tr_frag(bb + ks * 16 * VROW, VROW);
              acc = __builtin_amdgcn_mfma_f32_32x32x16_bf16(af, bf, acc, 0, 0, 0); }
          GAS bf16_t* sp = (GAS bf16_t*)S + (sbase * 4 + h) * 2048 + (size_t)(vb * 32 + r32) * 32 + 4 * hi;
#pragma unroll
          for (int g4 = 0; g4 < 4; ++g4) { u32x2 w; w.x = pk2(acc[4 * g4], acc[4 * g4 + 1]); w.y = pk2(acc[4 * g4 + 2], acc[4 * g4 + 3]); *(GAS u32x2*)(sp + 8 * g4) = w; } }
    }
}
constexpr int L_AB = 32768;
__device__ __forceinline__ void g2_scan(LAS unsigned char* lds, bf16_t* S, const float* DEC, int rank, int nranks) {
    const int tid = ltid(), el = tid & 127, seg = tid >> 7;
    LAS float* ab = (LAS float*)(lds + L_AB);
    for (int g0 = rank * 128; g0 < 4 * 8192; g0 += nranks * 128) {
        const int g = g0 + el, e = g & 8191, db = g >> 13, dir = db >> 1;
        const int n0 = dir ? (NCHUNK - 1 - seg * 64) : seg * 64;
        GAS bf16_t* sp = (GAS bf16_t*)S + ((size_t)db * NCHUNK + n0) * 8192 + e; const GAS float* dp = (const GAS float*)DEC + ((size_t)db * NCHUNK + n0) * 128 + (e >> 11) * 32 + (e & 31);
        const long ss = dir ? -8192 : 8192, ds = dir ? -128 : 128;
        float kv[64], dc[64];
        {   const GAS bf16_t* p = sp; const GAS float* q = dp;
#pragma unroll
            for (int i = 0; i < 64; ++i) { kv[i] = __builtin_bit_cast(float, (unsigned)*p << 16); dc[i] = *q; p += ss; q += ds; asm volatile("" : "+v"(p), "+v"(q)); } }
        float state = 0.f, cp = 1.f;
#pragma unroll
        for (int i = 0; i < 64; ++i) { const float k = kv[i], d = dc[i]; kv[i] = state; dc[i] = cp; state = fmaf(d, state, k); cp *= d; }
        __syncthreads();
        ab[(seg * 128 + el) * 2] = cp; ab[(seg * 128 + el) * 2 + 1] = state;
        __syncthreads();
        float sin = 0.f;
#pragma unroll
        for (int q = 0; q < 3; ++q) { const float aq = ab[(q * 128 + el) * 2], bq = ab[(q * 128 + el) * 2 + 1]; sin = (q < seg) ? fmaf(aq, sin, bq) : sin; }
        {   GAS bf16_t* p = sp;
#pragma unroll
            for (int i = 0; i < 64; ++i) { *p = (bf16_t)f2bf(fmaf(dc[i], sin, kv[i])); p += ss; asm volatile("" : "+v"(p)); } }
    }
}
__device__ __forceinline__ void g3_dir(LAS unsigned char* lds, const int dir, const u32x4 (&qw)[2], const u32x4 (&kw)[2], const u32x4 (&sv)[4], f32x16 (&o)[2]) {
    const int tid = ltid(), wid = tid >> 6, lane = tid & 63, r32 = lane & 31, hi = lane >> 5;
    const int h = wid >> 1, ib = wid & 1, iq = ib * 32 + r32;
    compute_la(lds, dir); __syncthreads();
    const LAS float* la = (const LAS float*)(lds + L_LA);
#pragma unroll
    for (int k = 0; k < 2; ++k) { const int id = tid + 512 * k, row = id >> 4, c8 = (id & 15) * 8;
        const u32x4 wq = qw[k], wk = kw[k];
        float qv[8] = {bflo(wq.x), bfhi(wq.x), bflo(wq.y), bfhi(wq.y), bflo(wq.z), bfhi(wq.z), bflo(wq.w), bfhi(wq.w)};
        float kv[8] = {bflo(wk.x), bfhi(wk.x), bflo(wk.y), bfhi(wk.y), bflo(wk.z), bfhi(wk.z), bflo(wk.w), bfhi(wk.w)};
#pragma unroll
        for (int j = 0; j < 8; ++j) { const float bb = la[row * 128 + c8 + j]; qv[j] *= 0.17677669529663687f * __expf(bb); kv[j] *= __expf(-bb); }
        u32x4 oq, ok; oq.x = pk2(qv[0], qv[1]); oq.y = pk2(qv[2], qv[3]); oq.z = pk2(qv[4], qv[5]); oq.w = pk2(qv[6], qv[7]);
        ok.x = pk2(kv[0], kv[1]); ok.y = pk2(kv[2], kv[3]); ok.z = pk2(kv[4], kv[5]); ok.w = pk2(kv[6], kv[7]);
        *(LAS u32x4*)(lds + L_QD + row * QROW + c8 * 2) = oq; *(LAS u32x4*)(lds + L_KI + row * QROW + c8 * 2) = ok; }
    __syncthreads();
    f32x16 p0 = {}, p1 = {}; bf16x8 qf[2];
#pragma unroll
    for (int ks = 0; ks < 2; ++ks) { const int cb = (h * 32 + ks * 16 + hi * 8) * 2;
        const bf16x8 a0 = *(const LAS bf16x8*)(lds + L_KI + r32 * QROW + cb), a1 = *(const LAS bf16x8*)(lds + L_KI + (32 + r32) * QROW + cb);
        qf[ks] = *(const LAS bf16x8*)(lds + L_QD + iq * QROW + cb);
        p0 = __builtin_amdgcn_mfma_f32_32x32x16_bf16(a0, qf[ks], p0, 0, 0, 0);
        p1 = __builtin_amdgcn_mfma_f32_32x32x16_bf16(a1, qf[ks], p1, 0, 0, 0); }
#pragma unroll
    for (int r = 0; r < 16; ++r) { const int j0 = crow(r, hi), j1 = 32 + j0;
        const bool k0 = dir ? (j0 > iq) : (j0 <= iq), k1 = dir ? (j1 > iq) : (j1 <= iq);
        p0[r] = k0 ? p0[r] : 0.f; p1[r] = k1 ? p1[r] : 0.f; }
    bf16x8 pa0, pa1, pa2, pa3;
    PK4(p0, 0, pa0); PK4(p0, 8, pa1); PK4(p1, 0, pa2); PK4(p1, 8, pa3);
    const LAS unsigned char* vbp = lds + L_V + tr_lane_off(lane, VROW) + h * 128;
#pragma unroll
    for (int vb = 0; vb < 2; ++vb) {
        const bf16x8 v0 = tr_frag(vbp + 0 * 16 * VROW + vb * 64, VROW), v1 = tr_frag(vbp + 1 * 16 * VROW + vb * 64, VROW);
        const bf16x8 v2 = tr_frag(vbp + 2 * 16 * VROW + vb * 64, VROW), v3 = tr_frag(vbp + 3 * 16 * VROW + vb * 64, VROW);
        o[vb] = __builtin_amdgcn_mfma_f32_32x32x16_bf16(pa0, v0, o[vb], 0, 0, 0);
        o[vb] = __builtin_amdgcn_mfma_f32_32x32x16_bf16(pa1, v1, o[vb], 0, 0, 0);
        o[vb] = __builtin_amdgcn_mfma_f32_32x32x16_bf16(pa2, v2, o[vb], 0, 0, 0);
        o[vb] = __builtin_amdgcn_mfma_f32_32x32x16_bf16(pa3, v3, o[vb], 0, 0, 0);
#pragma unroll
        for (int ks = 0; ks < 2; ++ks) o[vb] = __builtin_amdgcn_mfma_f32_32x32x16_bf16(qf[ks], __builtin_bit_cast(bf16x8, sv[vb * 2 + ks]), o[vb], 0, 0, 0);
    }
    __syncthreads();
}
__device__ __forceinline__ void g3_unit(LAS unsigned char* lds, const bf16_t* P, const bf16_t* S, bf16_t* CAT, int cidx) {
    const int tid = ltid(), wid = tid >> 6, lane = tid & 63, r32 = lane & 31, hi = lane >> 5;
    const int b = cidx >> 8, n = cidx & 255, token0 = cidx * 64;
    const int h = wid >> 1, ib = wid & 1;
    __syncthreads();
    u32x4 vv[4], aw = {}, qw[2], kw[2], gw[4], sv0[4], sv1[4];
#pragma unroll
    for (int k = 0; k < 4; ++k) { const int id = tid + 512 * k, row = id >> 5, c = id & 31;
        vv[k] = *(const GAS u32x4*)((const GAS bf16_t*)P + (size_t)(token0 + row) * PW + PC_GV + c * 8); }
    if (tid < 256) aw = *(const GAS u32x4*)((const GAS bf16_t*)P + (size_t)(token0 + (tid >> 2)) * PW + PC_AF + (tid & 3) * 8);
#pragma unroll
    for (int k = 0; k < 2; ++k) { const int id = tid + 512 * k, row = id >> 4, c8 = (id & 15) * 8;
        qw[k] = *(const GAS u32x4*)((const GAS bf16_t*)P + (size_t)(token0 + row) * PW + PC_GQ + c8);
        kw[k] = *(const GAS u32x4*)((const GAS bf16_t*)P + (size_t)(token0 + row) * PW + PC_GK + c8); }
    {   const GAS bf16_t* sg = (const GAS bf16_t*)S + ((size_t)((0 * 2 + b) * NCHUNK + n) * 4 + h) * 2048 + (size_t)r32 * 32 + hi * 8;
#pragma unroll
        for (int vb = 0; vb < 2; ++vb)
#pragma unroll
            for (int ks = 0; ks < 2; ++ks) sv0[vb * 2 + ks] = *(const GAS u32x4*)(sg + vb * 32 * 32 + ks * 16); }
    const int et = tid >> 3, ehh = (tid >> 1) & 3, ehalf = tid & 1;
    {   const GAS bf16_t* gp = (const GAS bf16_t*)P + (size_t)(token0 + et) * PW + PC_GG + ehh * 64 + ehalf * 32;
#pragma unroll
        for (int k = 0; k < 4; ++k) gw[k] = *(const GAS u32x4*)(gp + 8 * k); }
    {   const GAS bf16_t* sg = (const GAS bf16_t*)S + ((size_t)((1 * 2 + b) * NCHUNK + n) * 4 + h) * 2048 + (size_t)r32 * 32 + hi * 8;
#pragma unroll
        for (int vb = 0; vb < 2; ++vb)
#pragma unroll
            for (int ks = 0; ks < 2; ++ks) sv1[vb * 2 + ks] = *(const GAS u32x4*)(sg + vb * 32 * 32 + ks * 16); }
#pragma unroll
    for (int k = 0; k < 4; ++k) { const int id = tid + 512 * k, row = id >> 5, c = id & 31; *(LAS u32x4*)(lds + L_V + row * VROW + c * 16) = vv[k]; }
    if (tid < 256) { LAS float* a = (LAS float*)(lds + L_A) + (tid >> 2) * 32 + (tid & 3) * 8;
        a[0] = bflo(aw.x); a[1] = bfhi(aw.x); a[2] = bflo(aw.y); a[3] = bfhi(aw.y); a[4] = bflo(aw.z); a[5] = bfhi(aw.z); a[6] = bflo(aw.w); a[7] = bfhi(aw.w); }
    __syncthreads();
    f32x16 o[2] = {};
    g3_dir(lds, 0, qw, kw, sv0, o);
    g3_dir(lds, 1, qw, kw, sv1, o);
    {
        LAS float* os = (LAS float*)(lds + L_LA);
#pragma unroll
        for (int vb = 0; vb < 2; ++vb)
#pragma unroll
            for (int r = 0; r < 16; ++r) os[(ib * 32 + crow(r, hi)) * OSROW + h * 64 + vb * 32 + r32] = o[vb][r];
    }
    __syncthreads();
    {
        const LAS float* os = (const LAS float*)(lds + L_LA) + et * OSROW + ehh * 64 + ehalf * 32; const LAS float* ng = (const LAS float*)(lds + L_NG) + ehalf * 32;
        float v[32]; float ss = 0.f;
#pragma unroll
        for (int j = 0; j < 8; ++j) { const f32x4 x = *(const LAS f32x4*)(os + 4 * j); v[4 * j] = x[0]; v[4 * j + 1] = x[1]; v[4 * j + 2] = x[2]; v[4 * j + 3] = x[3]; ss += (x[0] * x[0] + x[1] * x[1]) + (x[2] * x[2] + x[3] * x[3]); }
        ss += shflx(ss, 1);
        const float rstd = rsqrtf(ss * (1.f / 64.f) + EPS);
        GAS bf16_t* op = (GAS bf16_t*)CAT + (size_t)(token0 + et) * DM + ehh * 64 + ehalf * 32;
#pragma unroll
        for (int k = 0; k < 4; ++k) { const u32x4 w = gw[k];
            const float gv[8] = {bflo(w.x), bfhi(w.x), bflo(w.y), bfhi(w.y), bflo(w.z), bfhi(w.z), bflo(w.w), bfhi(w.w)}; float ov[8];
#pragma unroll
            for (int j = 0; j < 8; ++j) { const float g = gv[j]; ov[j] = v[8 * k + j] * rstd * ng[8 * k + j] * (g * __builtin_amdgcn_rcpf(1.f + __expf(-g))); }
            u32x4 ow; ow.x = pk2(ov[0], ov[1]); ow.y = pk2(ov[2], ov[3]); ow.z = pk2(ov[4], ov[5]); ow.w = pk2(ov[6], ov[7]);
            *(GAS u32x4*)(op + 8 * k) = ow; }
    }
}
}

namespace fnet {
constexpr int ZROW = 320, L_Z = 0, LDS_BYTES = 128 * ZROW;
constexpr int UROW = 144, L_U = 65536;
template <int STEP>
__device__ __forceinline__ void phase(LAS unsigned char* lds, const bf16_t* src, bf16_t* dst, const bf16_t* DFTW, const bf16_t* FMB) {
    const int tid = ltid(), wid = tid >> 6, lane = tid & 63, r32 = lane & 31, hi = lane >> 5;
    const int kb = wid >> 1, db = wid & 1;
    bf16x8 wr[8], wi[8], nwi[8];
#pragma unroll
    for (int ks = 0; ks < 8; ++ks) { const size_t off = (size_t)(32 * kb + r32) * 128 + ks * 16 + hi * 8;
        wr[ks] = *(const GAS bf16x8*)((const GAS bf16_t*)DFTW + off);
        if (STEP == 1) wi[ks] = *(const GAS bf16x8*)((const GAS bf16_t*)DFTW + 16384 + off);
        nwi[ks] = *(const GAS bf16x8*)((const GAS bf16_t*)DFTW + 32768 + off); }
    const LAS unsigned char* zb = lds + L_Z + tr_lane_off(lane, ZROW) + db * 64;
    u32x4 zt[4];
#define FN_LOAD(u_) do { const int ub_ = (u_) >> 9, ui_ = ((u_) >> 2) & 127, ug_ = (u_) & 3; \
        if (STEP == 1) { _Pragma("unroll") for (int k = 0; k < 2; ++k) { const int id = tid + 512 * k, row = id >> 3, c = id & 7;     \
            zt[k] = *(const GAS u32x4*)((const GAS bf16_t*)src + (size_t)(ub_ * SEQ + 128 * row + ui_) * PW + PC_U + ug_ * 64 + c * 8); } } \
        else { _Pragma("unroll") for (int k = 0; k < 4; ++k) { const int id = tid + 512 * k, row = id >> 4, c = id & 15; \
            zt[k] = *(const GAS u32x4*)((const GAS bf16_t*)src + (size_t)(ub_ * SEQ + ui_ * 128 + row) * 512 + ug_ * 128 + c * 8); } } } while (0)
    if (lbid() < 1024) FN_LOAD(lbid());
    for (int u = lbid(); u < 1024; u += gridDim.x) {
        const int b = u >> 9, idx = (u >> 2) & 127, g = u & 3;
        bf16x8 mb[4];
        if (STEP == 1) { const GAS bf16_t* mp = (const GAS bf16_t*)FMB + ((size_t)g * 128 + (wid & 3) * 32 + r32) * 64 + hi * 8;
#pragma unroll
            for (int ks = 0; ks < 4; ++ks) mb[ks] = *(const GAS bf16x8*)(mp + ks * 16); }
        __syncthreads();
        if (STEP == 1) {
#pragma unroll
            for (int k = 0; k < 2; ++k) { const int id = tid + 512 * k, row = id >> 3, c = id & 7; *(LAS u32x4*)(lds + L_U + row * UROW + c * 16) = zt[k]; }
        } else {
#pragma unroll
            for (int k = 0; k < 4; ++k) { const int id = tid + 512 * k, row = id >> 4, c = id & 15; *(LAS u32x4*)(lds + L_Z + row * ZROW + c * 16) = zt[k]; }
        }
        __syncthreads();
        if (u + (int)gridDim.x < 1024) FN_LOAD(u + (int)gridDim.x);
        if (STEP == 1) {
            const int cb = wid & 3, rb0 = 2 * (wid >> 2);
            f32x16 za = {}, zc = {};
#pragma unroll
            for (int ks = 0; ks < 4; ++ks) {
                const bf16x8 a0 = *(const LAS bf16x8*)(lds + L_U + (rb0 * 32 + r32) * UROW + (ks * 16 + hi * 8) * 2), a1 = *(const LAS bf16x8*)(lds + L_U + (rb0 * 32 + 32 + r32) * UROW + (ks * 16 + hi * 8) * 2);
                za = __builtin_amdgcn_mfma_f32_32x32x16_bf16(a0, mb[ks], za, 0, 0, 0);
                zc = __builtin_amdgcn_mfma_f32_32x32x16_bf16(a1, mb[ks], zc, 0, 0, 0); }
            LAS bf16_t* zw = (LAS bf16_t*)(lds + L_Z) + cb * 32 + r32;
#pragma unroll
            for (int r = 0; r < 16; ++r) { zw[(rb0 * 32 + crow(r, hi)) * (ZROW / 2)] = (bf16_t)f2bf(za[r]); zw[(rb0 * 32 + 32 + crow(r, hi)) * (ZROW / 2)] = (bf16_t)f2bf(zc[r]); }
            __syncthreads();
        }
        f32x16 cr = {}, ci = {};
#pragma unroll
        for (int ks = 0; ks < 8; ++ks) {
            const bf16x8 br = tr_frag(zb + ks * 16 * ZROW, ZROW), bi = tr_frag(zb + ks * 16 * ZROW + 128, ZROW);
            cr = __builtin_amdgcn_mfma_f32_32x32x16_bf16(wr[ks], br, cr, 0, 0, 0);
            cr = __builtin_amdgcn_mfma_f32_32x32x16_bf16(nwi[ks], bi, cr, 0, 0, 0);
            if (STEP == 1) { ci = __builtin_amdgcn_mfma_f32_32x32x16_bf16(wi[ks], br, ci, 0, 0, 0);
                             ci = __builtin_amdgcn_mfma_f32_32x32x16_bf16(wr[ks], bi, ci, 0, 0, 0); }
        }
        if (STEP == 1) {
#pragma unroll
            for (int r = 0; r < 16; ++r) { const int k1 = 32 * kb + crow(r, hi); const int mm = (idx * k1) & 16383;
                const float rev = (float)mm * (1.f / 16384.f); const float cs = __builtin_amdgcn_cosf(rev), sn = -__builtin_amdgcn_sinf(rev);
                const float yr = cr[r] * cs - ci[r] * sn, yi = cr[r] * sn + ci[r] * cs;
                GAS bf16_t* op = (GAS bf16_t*)dst + (size_t)(b * SEQ + k1 * 128 + idx) * 512 + g * 128 + db * 32 + r32;
                op[0] = (bf16_t)f2bf(yr); op[64] = (bf16_t)f2bf(yi); }
        } else {
#pragma unroll
            for (int r = 0; r < 16; ++r) { const int k2 = 32 * kb + crow(r, hi);
                ((GAS bf16_t*)dst)[(size_t)(b * SEQ + idx + 128 * k2) * DM + 256 + g * 64 + db * 32 + r32] = (bf16_t)f2bf(cr[r]); }
        }
    }
#undef FN_LOAD
}
}

namespace nrm {
struct Row { f32x4 v[2][2]; u32x4 a[2], c[2], d[2]; };
template <bool ADD_Y, bool XBF>
__device__ __forceinline__ void load_row(Row& r, const void* xin, const bf16_t* Y, const bf16_t* D, int t, int lane) {
#pragma unroll
    for (int k = 0; k < 2; ++k) { const size_t p = (size_t)t * DM + 8 * lane + 512 * k;
        if (XBF) { const u32x4 w = *(const GAS u32x4*)((const GAS bf16_t*)xin + p); r.v[k][0] = (f32x4){bflo(w.x), bfhi(w.x), bflo(w.y), bfhi(w.y)}; r.v[k][1] = (f32x4){bflo(w.z), bfhi(w.z), bflo(w.w), bfhi(w.w)}; }
        else { r.v[k][0] = *(const GAS f32x4*)((const GAS float*)xin + p); r.v[k][1] = *(const GAS f32x4*)((const GAS float*)xin + p + 4); }
        if (ADD_Y) { r.a[k] = *(const GAS u32x4*)((const GAS bf16_t*)Y + p); r.c[k] = *(const GAS u32x4*)((const GAS bf16_t*)Y + (size_t)T * DM + p); if (D) r.d[k] = *(const GAS u32x4*)((const GAS bf16_t*)D + p); } }
}
template <bool ADD_Y, bool FINAL, bool XBF = false>
__device__ __forceinline__ void phase(const void* xin, const bf16_t* Y, const bf16_t* D, bf16_t* xout, const float* g, bf16_t* XN, float* OUT) {
    const int lane = ltid() & 63, gw = lbid() * 8 + (ltid() >> 6), NGW = gridDim.x * 8;
    f32x4 gv[2][2];
#pragma unroll
    for (int k = 0; k < 2; ++k) { gv[k][0] = *(const GAS f32x4*)((const GAS float*)g + 8 * lane + 512 * k); gv[k][1] = *(const GAS f32x4*)((const GAS float*)g + 8 * lane + 512 * k + 4); }
    Row cur, nxt;
    if (gw < T) load_row<ADD_Y, XBF>(cur, xin, Y, D, gw, lane);
    for (int t = gw; t < T; t += NGW) {
        nxt = cur;
        if (t + NGW < T) load_row<ADD_Y, XBF>(nxt, xin, Y, D, t + NGW, lane);
        f32x4 v[2][2]; float ss = 0.f;
#pragma unroll
        for (int k = 0; k < 2; ++k) { const size_t p = (size_t)t * DM + 8 * lane + 512 * k;
            v[k][0] = cur.v[k][0]; v[k][1] = cur.v[k][1];
            if (ADD_Y) {
                const u32x4 a = cur.a[k], c = cur.c[k], d = cur.d[k];
                if (D) { v[k][0] += (f32x4){bflo(d.x), bfhi(d.x), bflo(d.y), bfhi(d.y)}; v[k][1] += (f32x4){bflo(d.z), bfhi(d.z), bflo(d.w), bfhi(d.w)}; }
                v[k][0] += (f32x4){bflo(a.x), bfhi(a.x), bflo(a.y), bfhi(a.y)} + (f32x4){bflo(c.x), bfhi(c.x), bflo(c.y), bfhi(c.y)};
                v[k][1] += (f32x4){bflo(a.z), bfhi(a.z), bflo(a.w), bfhi(a.w)} + (f32x4){bflo(c.z), bfhi(c.z), bflo(c.w), bfhi(c.w)};
            }
            if (!FINAL && xout) { u32x4 xw; xw.x = pk2(v[k][0][0], v[k][0][1]); xw.y = pk2(v[k][0][2], v[k][0][3]); xw.z = pk2(v[k][1][0], v[k][1][1]); xw.w = pk2(v[k][1][2], v[k][1][3]); *(GAS u32x4*)((GAS bf16_t*)xout + p) = xw; }
#pragma unroll
            for (int q = 0; q < 2; ++q) ss += (v[k][q][0] * v[k][q][0] + v[k][q][1] * v[k][q][1]) + (v[k][q][2] * v[k][q][2] + v[k][q][3] * v[k][q][3]);
        }
        const float rstd = rsqrtf(wave_sum(ss) * (1.f / DM) + EPS);
#pragma unroll
        for (int k = 0; k < 2; ++k) { const size_t p = (size_t)t * DM + 8 * lane + 512 * k;
            const f32x4 a = v[k][0] * rstd * gv[k][0], c = v[k][1] * rstd * gv[k][1];
            if (FINAL) { *(GAS f32x4*)((GAS float*)OUT + p) = a; *(GAS f32x4*)((GAS float*)OUT + p + 4) = c; }
            else if (XN) { u32x4 w; w.x = pk2(a[0], a[1]); w.y = pk2(a[2], a[3]); w.z = pk2(c[0], c[1]); w.w = pk2(c[2], c[3]); *(GAS u32x4*)((GAS bf16_t*)XN + p) = w; }
        }
        if (!FINAL && OUT && lane == 0) ((GAS float*)OUT)[t] = rstd;
        cur = nxt;
    }
}
}

namespace moe {
constexpr int L_LOG = 0;
constexpr int L_HIST = 24576;
constexpr int L_TAB = 24576 + 256;
constexpr int WRS = 272;
constexpr int L_WRC = 32768, WRT_BYTES = 48 * WRS, WRC_BYTES = 2 * WRT_BYTES, L_G2 = L_WRC + 2 * WRC_BYTES;
static_assert(L_G2 + 4096 <= 131072, "route lds map");
template <bool XBF>
__device__ __forceinline__ void route_phase(LAS unsigned char* lds, const void* XA, const bf16_t* D, const bf16_t* WRH, const bf16_t* WRL, const float* brg, const float* bre, const float* g2, int* EID, float* EW, float* RS2, int* CNT, bf16_t* XN2) {
    const int tid = ltid(), wid = tid >> 6, lane = tid & 63, r = lane & 15, q = lane >> 4;
    LAS float* lw = (LAS float*)(lds + L_LOG) + wid * (16 * 48);
    LAS int* hist = (LAS int*)(lds + L_HIST);
    LAS float* gl2 = (LAS float*)(lds + L_G2);
    __syncthreads();
    (void)gl2; (void)g2;
#define RT_WLOAD(c) _Pragma("unroll") for (int k = 0; k < 3; ++k) { const int id = tid + 512 * k, tb = id >= 768, rem = id - 768 * tb; \
        wn[k] = *(const GAS u32x4*)((tb ? (const GAS bf16_t*)WRL : (const GAS bf16_t*)WRH) + (size_t)(rem >> 4) * DM + (c) * 128 + (rem & 15) * 8); }
#define RT_WWRITE(buf) _Pragma("unroll") for (int k = 0; k < 3; ++k) { const int id = tid + 512 * k, tb = id >= 768, rem = id - 768 * tb; \
        *(LAS u32x4*)(lds + L_WRC + (buf) * WRC_BYTES + tb * WRT_BYTES + (rem >> 4) * WRS + (rem & 15) * 16) = wn[k]; }
#define RT_XLOAD(dst, ddst, c) _Pragma("unroll") for (int s = 0; s < 4; ++s) { if (XBF) { dst[2 * s] = __builtin_bit_cast(f32x4, *(const GAS u32x4*)(xpb + (c) * 128 + 32 * s)); } else { dst[2 * s] = *(const GAS f32x4*)(xp + (c) * 128 + 32 * s); dst[2 * s + 1] = *(const GAS f32x4*)(xp + (c) * 128 + 32 * s + 4); } ddst[s] = *(const GAS u32x4*)(dp + (c) * 128 + 32 * s); }
    for (int tile = lbid(); tile < T / 128; tile += gridDim.x) {
        __syncthreads();
        if (tid < 32) hist[tid] = 0;
        const int t0 = tile * 128 + wid * 16;
        const GAS float* xp = (const GAS float*)XA + (size_t)(t0 + r) * DM + 8 * q; const GAS bf16_t* xpb = (const GAS bf16_t*)XA + (size_t)(t0 + r) * DM + 8 * q; (void)xp; (void)xpb;
        const GAS bf16_t* dp = (const GAS bf16_t*)D + (size_t)(t0 + r) * DM + 8 * q;
        GAS bf16_t* op = (GAS bf16_t*)XN2 + (size_t)(t0 + r) * DM + 8 * q;
        u32x4 wn[3]; f32x4 x[2][8]; u32x4 xd[2][4];
        RT_WLOAD(0); RT_XLOAD(x[0], xd[0], 0);
        RT_WWRITE(0);
        RT_WLOAD(1);
        __syncthreads();
        f32x4 acc0 = {}, acc1 = {}, acc2 = {}; float ss = 0.f;
#pragma unroll
        for (int c = 0; c < 8; ++c) {
            if (c < 7) { RT_WWRITE((c + 1) & 1); RT_XLOAD(x[(c + 1) & 1], xd[(c + 1) & 1], c + 1); }
            if (c < 6) { RT_WLOAD(c + 2); }
            const LAS unsigned char* wl = lds + L_WRC + (c & 1) * WRC_BYTES + r * WRS + q * 16;
#pragma unroll
            for (int s = 0; s < 4; ++s) {
                const u32x4 dw = xd[c & 1][s];
                f32x4 xv0, xv1;
                if (XBF) { const u32x4 xw = __builtin_bit_cast(u32x4, x[c & 1][2 * s]); xv0 = (f32x4){bflo(xw.x), bfhi(xw.x), bflo(xw.y), bfhi(xw.y)}; xv1 = (f32x4){bflo(xw.z), bfhi(xw.z), bflo(xw.w), bfhi(xw.w)}; }
                else { xv0 = x[c & 1][2 * s]; xv1 = x[c & 1][2 * s + 1]; }
                const f32x4 a0 = xv0 + (f32x4){bflo(dw.x), bfhi(dw.x), bflo(dw.y), bfhi(dw.y)}, a1 = xv1 + (f32x4){bflo(dw.z), bfhi(dw.z), bflo(dw.w), bfhi(dw.w)};
                ss += ((a0[0] * a0[0] + a0[1] * a0[1]) + (a0[2] * a0[2] + a0[3] * a0[3])) + ((a1[0] * a1[0] + a1[1] * a1[1]) + (a1[2] * a1[2] + a1[3] * a1[3]));
                u32x4 w; w.x = pk2(a0[0], a0[1]); w.y = pk2(a0[2], a0[3]); w.z = pk2(a1[0], a1[1]); w.w = pk2(a1[2], a1[3]);
                *(GAS u32x4*)(op + c * 128 + 32 * s) = w;
                u32x4 xh, xl; xh.x = cvtpk(a0[0], a0[1]); xh.y = cvtpk(a0[2], a0[3]); xh.z = cvtpk(a1[0], a1[1]); xh.w = cvtpk(a1[2], a1[3]);
                xl.x = cvtpk(a0[0] - bflo(xh.x), a0[1] - bfhi(xh.x)); xl.y = cvtpk(a0[2] - bflo(xh.y), a0[3] - bfhi(xh.y)); xl.z = cvtpk(a1[0] - bflo(xh.z), a1[1] - bfhi(xh.z)); xl.w = cvtpk(a1[2] - bflo(xh.w), a1[3] - bfhi(xh.w));
                const bf16x8 ah = __builtin_bit_cast(bf16x8, xh), al = __builtin_bit_cast(bf16x8, xl);
#pragma unroll
                for (int nb = 0; nb < 3; ++nb) {
                    const bf16x8 wh = *(const LAS bf16x8*)(wl + nb * 16 * WRS + s * 64), wlo = *(const LAS bf16x8*)(wl + WRT_BYTES + nb * 16 * WRS + s * 64);
                    f32x4& acc = nb == 0 ? acc0 : nb == 1 ? acc1 : acc2;
                    acc = __builtin_amdgcn_mfma_f32_16x16x32_bf16(ah, wh, acc, 0, 0, 0);
                    acc = __builtin_amdgcn_mfma_f32_16x16x32_bf16(al, wh, acc, 0, 0, 0);
                    acc = __builtin_amdgcn_mfma_f32_16x16x32_bf16(ah, wlo, acc, 0, 0, 0); }
            }
            __syncthreads();
        }
#pragma unroll
        for (int i = 0; i < 4; ++i) { lw[(4 * q + i) * 48 + r] = acc0[i]; lw[(4 * q + i) * 48 + 16 + r] = acc1[i]; lw[(4 * q + i) * 48 + 32 + r] = acc2[i]; }
        ss += shflx(ss, 16); ss += shflx(ss, 32);
        const float rstd = rsqrtf(ss * (1.f / DM) + EPS);
        LDS_WAIT();
        if (lane < 16) {
            const int t = t0 + lane; const LAS float* lg = lw + lane * 48;
            float gl[4]; float gmax = -3.0e38f; int gi = 0;
#pragma unroll
            for (int i = 0; i < 4; ++i) { gl[i] = lg[i] * rstd + ((const GAS float*)brg)[i]; if (gl[i] > gmax) { gmax = gl[i]; gi = i; } }
            float gsum = 0.f;
#pragma unroll
            for (int i = 0; i < 4; ++i) gsum += __expf(gl[i] - gmax);
            const float grp_w = 1.f / gsum;
            float el[8]; float m0 = -3.0e38f; int i0 = 0;
#pragma unroll
            for (int i = 0; i < 8; ++i) { el[i] = lg[4 + gi * 8 + i] * rstd + ((const GAS float*)bre)[gi * 8 + i]; if (el[i] > m0) { m0 = el[i]; i0 = i; } }
            float m1 = -3.0e38f; int i1 = 0;
#pragma unroll
            for (int i = 0; i < 8; ++i) { if (i != i0 && el[i] > m1) { m1 = el[i]; i1 = i; } }
            const float p1 = __expf(m1 - m0), inv = 1.f / (1.f + p1);
            const int e0 = gi * 8 + i0, e1 = gi * 8 + i1;
            ((GAS int*)EID)[2 * t] = e0; ((GAS int*)EID)[2 * t + 1] = e1;
            ((GAS float*)EW)[2 * t] = grp_w * inv; ((GAS float*)EW)[2 * t + 1] = grp_w * p1 * inv;
            ((GAS float*)RS2)[t] = rstd;
            __hip_atomic_fetch_add(&hist[e0], 1, __ATOMIC_RELAXED, __HIP_MEMORY_SCOPE_WORKGROUP); __hip_atomic_fetch_add(&hist[e1], 1, __ATOMIC_RELAXED, __HIP_MEMORY_SCOPE_WORKGROUP);
        }
        __syncthreads();
        if (tid < 32) ((GAS int*)CNT)[tile * 32 + tid] = hist[tid];
    }
#undef RT_WLOAD
#undef RT_WWRITE
#undef RT_XLOAD
}
__device__ __forceinline__ void scatter_phase(LAS unsigned char* lds, const int* EID, const float* EW, const float* RS2, const int* CNT, int* SRC, float* WGT, int* ROWTOK, float* RSS, int* TILEE) {
    const int tid = ltid();
    LAS int* ptot = (LAS int*)(lds + L_TAB); LAS int* pbef = ptot + 512; LAS int* base = pbef + 512; LAS int* segb = base + 32; LAS int* tot = segb + 32; LAS int* pe = tot + 32;
    for (int tile = lbid(); tile < T / 128; tile += gridDim.x) {
        __syncthreads();
        { const int e = tid & 31, part = tid >> 5; int s = 0, bf = 0;
          for (int i = 0; i < 16; ++i) { const int tt = part * 16 + i; const int c = ((const GAS int*)CNT)[tt * 32 + e]; s += c; bf += (tt < tile) ? c : 0; }
          ptot[part * 32 + e] = s; pbef[part * 32 + e] = bf; }
        if (tid < 256) pe[tid] = ((const GAS int*)EID)[tile * 256 + tid];
        __syncthreads();
        if (tid < 32) { int s = 0, bf = 0; for (int p = 0; p < 16; ++p) { s += ptot[p * 32 + tid]; bf += pbef[p * 32 + tid]; } tot[tid] = s; base[tid] = bf; }
        __syncthreads();
        if (tid == 0) { int run = 0; for (int e = 0; e < 32; ++e) { segb[e] = run; run += (tot[e] + 255) & ~255; } }
        __syncthreads();
        if (tid < 256) { const int me = pe[tid]; int rank = 0; for (int p = 0; p < 256; ++p) rank += (p < tid && pe[p] == me) ? 1 : 0;
            const int ps = segb[me] + base[me] + rank;
            ((GAS int*)SRC)[ps] = tile * 256 + tid; ((GAS float*)WGT)[ps] = ((const GAS float*)EW)[tile * 256 + tid]; ((GAS int*)ROWTOK)[ps] = tile * 128 + (tid >> 1); ((GAS float*)RSS)[ps] = ((const GAS float*)RS2)[tile * 128 + (tid >> 1)]; }
        for (int e = tile; e < 32; e += T / 128) {
            const int s0 = segb[e], n = tot[e], np = (n + 255) & ~255;
            for (int i = n + tid; i < np; i += 512) { ((GAS int*)SRC)[s0 + i] = -1; ((GAS int*)ROWTOK)[s0 + i] = 0; ((GAS float*)RSS)[s0 + i] = 0.f; }
            for (int i = tid; i < np / 256; i += 512) ((GAS int*)TILEE)[s0 / 256 + i] = e;
            if (e == 31 && tid == 0) ((GAS int*)TILEE)[MT_MAX] = (s0 + np) / 256;
        }
    }
}
}

namespace pro {
constexpr int TSTR = 65;
template <class RowMap>
__device__ __forceinline__ void transpose_tile(LAS float* tile, const float* src, int N, int k0, int n0, const RowMap& rm, const float* kscale, bf16_t* dst, int ldd) {
    const int tid = ltid();
    { const int kk = tid >> 4, n4 = (tid & 15) * 4;
#pragma unroll
      for (int r = 0; r < 2; ++r) { const int k = kk + 32 * r; const f32x4 v = *(const GAS f32x4*)((const GAS float*)src + (size_t)(k0 + k) * N + n0 + n4);
          tile[k * TSTR + n4] = v[0]; tile[k * TSTR + n4 + 1] = v[1]; tile[k * TSTR + n4 + 2] = v[2]; tile[k * TSTR + n4 + 3] = v[3]; } }
    __syncthreads();
    { const int nn = tid >> 3, k8 = (tid & 7) * 8; const int drow = rm(n0 + nn);
      if (drow >= 0) { float v[8];
#pragma unroll
          for (int j = 0; j < 8; ++j) v[j] = tile[(k8 + j) * TSTR + nn] * (kscale ? ((const GAS float*)kscale)[k0 + k8 + j] : 1.f);
          u32x4 w; w.x = pk2(v[0], v[1]); w.y = pk2(v[2], v[3]); w.z = pk2(v[4], v[5]); w.w = pk2(v[6], v[7]);
          *(GAS u32x4*)((GAS bf16_t*)dst + (size_t)drow * ldd + k0 + k8) = w; } }
    __syncthreads();
}
struct MapIdent { __device__ int operator()(int c) const { return c; } };
struct MapWin { __device__ int operator()(int c) const {
    return c < RC_AF ? c : c < RC_AB ? PC_AF + (c - RC_AF) : c < RC_FU ? PC_AB + (c - RC_AB) : c < RC_CQ ? PC_U + (c - RC_FU) : c < RC_CKV ? PC_CQ + (c - RC_CQ) : c < RC_KR ? PC_CKV + (c - RC_CKV) : PC_KR + (c - RC_KR); } };
struct MapWuq { __device__ int operator()(int c) const { const int head = c / 96, e = c - head * 96; if (e < 64) return 64 * head + e; const int i = e - 64, part = i >> 4, idx = i & 15;
    return 64 * (8 + (head >> 1)) + 16 * (2 * (head & 1) + (idx >> 3)) + 8 * part + (idx & 7); } };
struct MapGU { int type; __device__ int operator()(int h) const { return 256 * (h >> 7) + 64 * ((h >> 5) & 3) + 16 * ((h >> 3) & 3) + 8 * ((h >> 2) & 1) + 4 * type + (h & 3); } };

struct In {
    const float *x; const int* positions; const float *norm1_g, *w_in, *wa_f, *ba_f, *wa_b, *ba_b, *gla_ng, *fnet_w, *qn_g, *w_uq, *kvn_g, *w_ukv, *w_out, *norm2_g, *w_rg, *b_rg, *w_re, *b_re, *w_gate, *w_up, *w_down, *final_g;
};
__device__ __forceinline__ void tables_phase(const In& in, unsigned char* ws) {
    const int gt = lbid() * 512 + ltid(), NT = gridDim.x * 512;
    GAS bf16_t* FM = (GAS bf16_t*)(ws + WS_FM);
    for (int i = gt; i < 2 * 4 * 64 * 64; i += NT) { const int d = i & 63, c = (i >> 6) & 63, lg = i >> 12;
        const GAS float* wm = (const GAS float*)in.fnet_w + (size_t)lg * 4096 + d; float re = 0.f, im = 0.f;
        for (int cp = 0; cp < 64; ++cp) { float sn, cs; sincospif((float)((c * cp) & 63) * (1.f / 32.f), &sn, &cs); const float w = wm[cp * 64]; re = fmaf(cs, w, re); im = fmaf(-sn, w, im); }
        FM[(size_t)(lg * 128 + d) * 64 + c] = (bf16_t)f2bf(re * (1.f / 1024.f)); FM[(size_t)(lg * 128 + 64 + d) * 64 + c] = (bf16_t)f2bf(im * (1.f / 1024.f)); }
    GAS bf16_t* DW = (GAS bf16_t*)(ws + WS_DFTW);
    for (int i = gt; i < 128 * 128; i += NT) { const int n = i & 127, k = i >> 7; float sn, cs; sincospif((float)((k * n) & 127) * (1.f / 64.f), &sn, &cs);
        DW[i] = (bf16_t)f2bf(cs); DW[16384 + i] = (bf16_t)f2bf(-sn); DW[32768 + i] = (bf16_t)f2bf(sn); }
    GAS float* RP = (GAS float*)(ws + WS_ROPE);
    for (int i = gt; i < T * 16; i += NT) { const int f = i & 15, t = i >> 4;
        const double b4 = (f & 3) == 0 ? 1.0 : (f & 3) == 1 ? 0.5623413251903491 : (f & 3) == 2 ? 0.31622776601683794 : 0.1778279410038923;
        const double dc = (f >> 2) == 0 ? 1.0 : (f >> 2) == 1 ? 0.1 : (f >> 2) == 2 ? 0.01 : 0.001;
        const double turns = (double)((const GAS int*)in.positions)[t] * (b4 * dc) * 0.15915494309189535;
        const double fr = turns - __builtin_floor(turns);
        float sn, cs; sincospif((float)(2.0 * fr), &sn, &cs);
        RP[(size_t)t * 32 + f] = cs; RP[(size_t)t * 32 + 16 + f] = sn; }
}
__device__ __forceinline__ void weights_phase(LAS unsigned char* lds, const In& in, unsigned char* ws) {
    const int tid = ltid(); LAS float* tile = (LAS float*)lds;
    constexpr int J_WIN = 16 * 23, J_WUQ = 4 * 12, J_WUKV = 2 * 16, J_WOUT = 16 * 16, J_L = J_WIN + J_WUQ + J_WUKV + J_WOUT;
    for (int job = lbid(); job < 2 * J_L; job += gridDim.x) {
        const int l = job / J_L; int r = job - l * J_L;
        if (r < J_WIN) { transpose_tile(tile, in.w_in + (size_t)l * DM * IN_W, IN_W, (r / 23) * 64, (r % 23) * 64, MapWin{}, in.norm1_g + (size_t)l * DM, (bf16_t*)(ws + WS_WIN) + (size_t)l * PW * DM, DM); continue; } r -= J_WIN;
        if (r < J_WUQ) { transpose_tile(tile, in.w_uq + (size_t)l * 256 * QW, QW, (r / 12) * 64, (r % 12) * 64, MapWuq{}, in.qn_g + l * 256, (bf16_t*)(ws + WS_WUQ) + (size_t)l * QW * 256, 256); continue; } r -= J_WUQ;
        if (r < J_WUKV) { transpose_tile(tile, in.w_ukv + (size_t)l * 128 * KVW, KVW, (r / 16) * 64, (r % 16) * 64, MapIdent{}, in.kvn_g + l * 128, (bf16_t*)(ws + WS_WUKV) + (size_t)l * KVW * 128, 128); continue; } r -= J_WUKV;
        transpose_tile(tile, in.w_out + (size_t)l * DM * DM, DM, (r / 16) * 64, (r % 16) * 64, MapIdent{}, nullptr, (bf16_t*)(ws + WS_WOUT) + (size_t)l * DM * DM, DM);
    }
    const int gt = lbid() * 512 + tid, NT = gridDim.x * 512;
    for (int i = gt; i < 2 * 64 * DM / 8; i += NT) { const int l = i / (64 * DM / 8), r = i - l * (64 * DM / 8);
        *(GAS u32x4*)((GAS bf16_t*)(ws + WS_WIN) + ((size_t)l * PW + PC_PAD) * DM + (size_t)r * 8) = (u32x4){0u, 0u, 0u, 0u}; }
    for (int i = gt; i < 2 * 48 * DM; i += NT) { const int k = i & 1023, n = (i >> 10) % 48, l = i / (48 * DM);
        const float g2 = ((const GAS float*)in.norm2_g)[l * DM + k];
        const float w = n < 4 ? ((const GAS float*)in.w_rg)[((size_t)l * DM + k) * 4 + n] : n < 36 ? ((const GAS float*)in.w_re)[((size_t)l * DM + k) * 32 + (n - 4)] : 0.f;
        const float v = g2 * w; const unsigned hb = f2bf(v); const float hf = __builtin_bit_cast(float, hb << 16);
        ((GAS bf16_t*)(ws + WS_WR))[i] = (bf16_t)hb; ((GAS bf16_t*)(ws + WS_WR))[2 * 48 * DM + i] = (bf16_t)f2bf(v - hf); }
}
__device__ __forceinline__ void moe_weights_phase(LAS unsigned char* lds, const In& in, unsigned char* ws, int l) {
    const int tid = ltid(), kk = tid >> 4, n4 = (tid & 15) * 4, nn = tid >> 3, k8 = (tid & 7) * 8;
    LAS float* tiles = (LAS float*)lds;
    constexpr int NJ = 32 * 192;
    const float* wg = in.w_gate; const float* wu = in.w_up; const float* wd = in.w_down; const float* g2 = in.norm2_g + (size_t)l * DM;
#define MW_DESC(job_) const int e_ = (job_) / 192, r_ = (job_) - e_ * 192, type_ = r_ >> 6, q_ = r_ & 63; \
        const size_t eo_ = ((size_t)l * 32 + e_) * DM * DEXP; \
        const float* src_ = (type_ == 0 ? wg : type_ == 1 ? wu : wd) + eo_; \
        const int N_ = type_ == 2 ? DM : DEXP, k0_ = (type_ == 2 ? (q_ >> 4) : (q_ >> 2)) * 64, n0_ = (type_ == 2 ? (q_ & 15) : (q_ & 3)) * 64;
    LAS float* g2l = tiles + 2 * 64 * TSTR;
    for (int i = tid; i < DM; i += 512) g2l[i] = ((const GAS float*)g2)[i];
    f32x4 v0 = {}, v1 = {};
    int job = lbid();
    if (job < NJ) { MW_DESC(job) v0 = *(const GAS f32x4*)((const GAS float*)src_ + (size_t)(k0_ + kk) * N_ + n0_ + n4); v1 = *(const GAS f32x4*)((const GAS float*)src_ + (size_t)(k0_ + kk + 32) * N_ + n0_ + n4); }
    int buf = 0;
    __syncthreads();
    for (; job < NJ; job += gridDim.x) {
        LAS float* tile = tiles + buf * (64 * TSTR);
        tile[kk * TSTR + n4] = v0[0]; tile[kk * TSTR + n4 + 1] = v0[1]; tile[kk * TSTR + n4 + 2] = v0[2]; tile[kk * TSTR + n4 + 3] = v0[3];
        tile[(kk + 32) * TSTR + n4] = v1[0]; tile[(kk + 32) * TSTR + n4 + 1] = v1[1]; tile[(kk + 32) * TSTR + n4 + 2] = v1[2]; tile[(kk + 32) * TSTR + n4 + 3] = v1[3];
        __syncthreads();
        { const int nj = job + (int)gridDim.x;
          if (nj < NJ) { MW_DESC(nj) v0 = *(const GAS f32x4*)((const GAS float*)src_ + (size_t)(k0_ + kk) * N_ + n0_ + n4); v1 = *(const GAS f32x4*)((const GAS float*)src_ + (size_t)(k0_ + kk + 32) * N_ + n0_ + n4); } }
        {   MW_DESC(job)
            const int n = n0_ + nn, drow = type_ == 2 ? n : MapGU{type_}(n);
            bf16_t* dst = type_ == 2 ? (bf16_t*)(ws + WS_WD) + (size_t)e_ * DM * DEXP : (bf16_t*)(ws + WS_WGU) + (size_t)e_ * 512 * DM;
            const int ldd = type_ == 2 ? DEXP : DM;
            float v[8];
#pragma unroll
            for (int j = 0; j < 8; ++j) v[j] = tile[(k8 + j) * TSTR + nn] * (type_ == 2 ? 1.f : g2l[k0_ + k8 + j]);
            u32x4 w; w.x = pk2(v[0], v[1]); w.y = pk2(v[2], v[3]); w.z = pk2(v[4], v[5]); w.w = pk2(v[6], v[7]);
            *(GAS u32x4*)((GAS bf16_t*)dst + (size_t)drow * ldd + k0_ + k8) = w; }
        buf ^= 1;
    }
#undef MW_DESC
    __syncthreads();
}
}

#ifdef SELFCHECK
namespace chk {
constexpr int NS = 48;
__device__ __forceinline__ float block_sum(float v, float* red) {
    v = wave_sum(v); __syncthreads(); if ((threadIdx.x & 63) == 0) red[threadIdx.x >> 6] = v; __syncthreads(); return red[0] + red[1] + red[2] + red[3];
}
__device__ __forceinline__ float block_max(float v, float* red) {
#pragma unroll
    for (int o = 1; o < 64; o <<= 1) v = fmaxf(v, __shfl_xor(v, o));
    __syncthreads(); if ((threadIdx.x & 63) == 0) red[threadIdx.x >> 6] = v; __syncthreads(); return fmaxf(fmaxf(red[0], red[1]), fmaxf(red[2], red[3]));
}
__device__ __forceinline__ void put_metric(unsigned char* ws, int id, float err, float ref_sq_sum, int n, float* red) {
    const float emax = block_max(err, red), rms = sqrtf(block_sum(ref_sq_sum, red) / (float)n + 1e-30f);
    if (threadIdx.x == 0) atomicMax((int*)(ws + WS_CTL + 49152) + id, __float_as_int(emax / rms));
}
__global__ void __launch_bounds__(256) check_kernel(pro::In in, unsigned char* ws) {
    __shared__ float xn[1024]; __shared__ float red[8]; __shared__ float vec[1024]; __shared__ float ored[4][64];
    const int tid = threadIdx.x, s = blockIdx.x, t = (int)(((long)s * 2731 + 77) % T), b = t / SEQ;
    const bf16_t* P = (const bf16_t*)(ws + WS_P); const unsigned char* Q = ws + WS_Q; const unsigned char* K8 = ws + WS_K8; const unsigned char* KV = ws + WS_KV; const unsigned char* KR = ws + WS_KR; const bf16_t* CAT = (const bf16_t*)(ws + WS_XN);
#define F8(p) __builtin_amdgcn_cvt_f32_fp8((int)(*(p)), 0)
    float* sc = (float*)(ws + WS_WGU) + (size_t)blockIdx.x * SEQ;
    { float ss = 0.f; for (int k = tid; k < 1024; k += 256) { const float v = in.x[(size_t)t * DM + k]; ss += v * v; }
      const float rstd = rsqrtf(block_sum(ss, red) / 1024.f + EPS);
      for (int k = tid; k < 1024; k += 256) xn[k] = in.x[(size_t)t * DM + k] * rstd * in.norm1_g[k]; }
    __syncthreads();
    { float err = 0.f, rsq = 0.f; int n = 0;
      for (int c = tid; c < IN_W; c += 256) { if (c >= RC_FU && c < RC_CQ) continue;
          const int pc = pro::MapWin{}(c); float ref = 0.f; for (int k = 0; k < 1024; ++k) ref = fmaf(xn[k], in.w_in[(size_t)k * IN_W + c], ref);
          err = fmaxf(err, fabsf(bf2f(P[(size_t)t * PW + pc]) - ref)); rsq += ref * ref; }
      put_metric(ws, 0, err, rsq, IN_W - 256, red); (void)n; }
    { for (int c = tid; c < 256; c += 256) { float u = 0.f; for (int k = 0; k < 1024; ++k) u = fmaf(xn[k], in.w_in[(size_t)k * IN_W + RC_FU + c], u); vec[c] = u; }
      __syncthreads();
      float err = 0.f, rsq = 0.f;
      for (int o = tid; o < 512; o += 256) { const int g = o >> 7, part = (o >> 6) & 1, d = o & 63; float ref = 0.f;
          for (int c = 0; c < 64; ++c) { float m = 0.f;
              for (int cp = 0; cp < 64; ++cp) { const float ang = -6.283185307179586f * (float)((c * cp) & 63) / 64.f; m = fmaf(part ? sinf(ang) : cosf(ang), in.fnet_w[(size_t)g * 4096 + cp * 64 + d], m); }
              ref = fmaf(vec[g * 64 + c], m * (1.f / 1024.f), ref); }
          err = fmaxf(err, fabsf(bf2f(P[(size_t)t * PW + PC_Z + o]) - ref)); rsq += ref * ref; }
      put_metric(ws, 1, err, rsq, 512, red); }
    { float ssq = 0.f, sskv = 0.f;
      for (int k = tid; k < 256; k += 256) { const float v = bf2f(P[(size_t)t * PW + PC_CQ + k]); ssq += v * v; }
      for (int k = tid; k < 128; k += 256) { const float v = bf2f(P[(size_t)t * PW + PC_CKV + k]); sskv += v * v; }
      const float rq = rsqrtf(block_sum(ssq, red) / 256.f + EPS), rkv = rsqrtf(block_sum(sskv, red) / 128.f + EPS);
      const double pos = (double)in.positions[t];
      float err = 0.f, rsq = 0.f;
      for (int c = tid; c < 768; c += 256) { float a = 0.f; for (int k = 0; k < 256; ++k) a = fmaf(bf2f(P[(size_t)t * PW + PC_CQ + k]) * in.qn_g[k], in.w_uq[(size_t)k * QW + c], a); vec[c] = a * rq; }
      __syncthreads();
      for (int c = tid; c < 768; c += 256) { const int h = c / 96, e = c % 96; float ref;
          if (e < 64) ref = vec[c];
          else { const int i = (e - 64) & 15; const double inv = exp2(-(double)i * (13.287712379549449 / 16.0)); const double ang = pos * inv; const double kk = rint(ang * 0.15915494309189535); const float r = (float)(ang - kk * 6.283185307179586);
                 const float cs = cosf(r), sn = sinf(r), x1 = vec[h * 96 + 64 + i], x2 = vec[h * 96 + 80 + i]; ref = (e < 80) ? x1 * cs - x2 * sn : x1 * sn + x2 * cs; }
          ref *= C2; err = fmaxf(err, fabsf(F8(Q + (size_t)t * QW + c) * (1.f / 16.f) - ref)); rsq += ref * ref; }
      put_metric(ws, 2, err, rsq, 768, red);
      err = 0.f; rsq = 0.f;
      for (int c = tid; c < 1024; c += 256) { float a = 0.f; for (int k = 0; k < 128; ++k) a = fmaf(bf2f(P[(size_t)t * PW + PC_CKV + k]) * in.kvn_g[k], in.w_ukv[(size_t)k * KVW + c], a);
          const float ref = a * rkv; if ((c & 127) < 64) err = fmaxf(err, fabsf(F8(K8 + ((size_t)t * 8 + (c >> 7)) * 64 + (c & 63)) - ref)); else err = fmaxf(err, fabsf(F8(KV + ((size_t)t * 8 + (c >> 7)) * 64 + (c & 63)) - ref)); rsq += ref * ref; }
      put_metric(ws, 3, err, rsq, 1024, red);
      err = 0.f; rsq = 0.f;
      for (int c = tid; c < 32; c += 256) { const int i = c & 15; const double inv = exp2(-(double)i * (13.287712379549449 / 16.0)); const double ang = pos * inv; const double kk = rint(ang * 0.15915494309189535); const float r = (float)(ang - kk * 6.283185307179586);
          const float cs = cosf(r), sn = sinf(r), x1 = bf2f(P[(size_t)t * PW + PC_KR + i]), x2 = bf2f(P[(size_t)t * PW + PC_KR + 16 + i]);
          const float ref = (c < 16) ? x1 * cs - x2 * sn : x1 * sn + x2 * cs; err = fmaxf(err, fabsf(F8(KR + (size_t)t * 32 + c) - ref)); rsq += ref * ref; }
      put_metric(ws, 4, err, rsq, 32, red); }
    for (int h = 0; h < 8; ++h) {
        __syncthreads();
        if (tid < 96) vec[tid] = F8(Q + (size_t)t * QW + h * 96 + tid) * (1.f / 16.f);
        __syncthreads();
        float mx = -3e38f;
        for (int j = tid; j < SEQ; j += 256) { const size_t kt = (size_t)b * SEQ + j; float a = 0.f;
            for (int d = 0; d < 64; ++d) a = fmaf(vec[d], F8(K8 + (kt * 8 + h) * 64 + d), a);
            for (int d = 0; d < 32; ++d) a = fmaf(vec[64 + d], F8(KR + kt * 32 + d), a);
            sc[j] = a; mx = fmaxf(mx, a); }
        mx = block_max(mx, red);
        const int kg = tid >> 6, c = tid & 63; float o = 0.f, l = 0.f;
        for (int j = kg; j < SEQ; j += 4) { const float p = exp2f(sc[j] - mx); l += p; o = fmaf(p, F8(KV + (((size_t)b * SEQ + j) * 8 + h) * 64 + c), o); }
        __syncthreads(); ored[kg][c] = o; if (c == 0) red[4 + kg] = l; __syncthreads();
        float err = 0.f, rsq = 0.f;
        if (tid < 64) { const float ref = (ored[0][tid] + ored[1][tid] + ored[2][tid] + ored[3][tid]) / (red[4] + red[5] + red[6] + red[7]);
            err = fabsf(bf2f(CAT[(size_t)t * DM + 512 + h * 64 + tid]) - ref); rsq = ref * ref; }
        put_metric(ws, 5, err, rsq, 64, red);
    }
}
}
#endif

constexpr int NWAVES = 8;
constexpr int LDS_MISC = 131072, LDS_BYTES = 147456;
constexpr int N_PHASES = 25;
#ifndef ALIGN_E
#define ALIGN_E true
#endif
struct Args { pro::In in; float* out; unsigned char* ws; int ph_lo, ph_hi, li, pad; };
static_assert(sizeof(Args) == 24 * 8 + 16 + 16, "Args has no padding");

__global__ void __launch_bounds__(NWAVES * 64, 2) fwd_kernel(Args args) {
    extern __shared__ __attribute__((aligned(16))) unsigned char lds_raw[];
    LAS unsigned char* lds = (LAS unsigned char*)lds_raw;
    const int tid = threadIdx.x;
    volatile LAS unsigned* misc = (volatile LAS unsigned*)(lds + LDS_MISC);
    if (tid < 64) misc[tid] = 0u;
    __syncthreads();
    XcdBarrier bar = xcd_barrier_post((unsigned*)(args.ws + WS_CTL) + 1024 + args.li * 4096, misc + 8);
    const int lo = args.ph_lo, hi = args.ph_hi;
#ifdef PREFIX_K
    const int skipm = args.pad;
#define SKIP(bit) ((skipm >> (bit)) & 1)
#else
#define SKIP(bit) 0
#endif
#ifndef PHMASK
#define PHMASK 0xFFFFFFFFu
#endif
#define IN(k) (((PHMASK >> ((k) < 2 ? (k) : 2 + ((k) - 2) % 11 + ((k) == 24 ? 11 : 0))) & 1u) && lo <= (k) && (k) < hi)
#ifndef DBL
#define DBL 0
#endif
#define REP(k) for (int rep_ = 0; rep_ < 1 + ((DBL >> (k)) & 1); ++rep_)
#ifndef SEAM_REPS
#define SEAM_REPS 1
#endif
#define SEAM(k) do { if (IN(k) && IN((k) + 1)) for (int sr_ = 0; sr_ < SEAM_REPS; ++sr_) xcd_barrier(bar); } while (0)
#define AS4 __attribute__((address_space(4)))
#define PH_BEGIN \
    unsigned long long kp_ = (unsigned long long)__builtin_amdgcn_kernarg_segment_ptr(); asm volatile("" : "+s"(kp_)); \
    const AS4 Args* ap_ = (const AS4 Args*)kp_; pro::In in; in.x = ap_->in.x; in.positions = ap_->in.positions; in.norm1_g = ap_->in.norm1_g; in.w_in = ap_->in.w_in; in.wa_f = ap_->in.wa_f; in.ba_f = ap_->in.ba_f; in.wa_b = ap_->in.wa_b; in.ba_b = ap_->in.ba_b; in.gla_ng = ap_->in.gla_ng; in.fnet_w = ap_->in.fnet_w; in.qn_g = ap_->in.qn_g; in.w_uq = ap_->in.w_uq; in.kvn_g = ap_->in.kvn_g; in.w_ukv = ap_->in.w_ukv; in.w_out = ap_->in.w_out; in.norm2_g = ap_->in.norm2_g; in.w_rg = ap_->in.w_rg; in.b_rg = ap_->in.b_rg; in.w_re = ap_->in.w_re; in.b_re = ap_->in.b_re; in.w_gate = ap_->in.w_gate; in.w_up = ap_->in.w_up; in.w_down = ap_->in.w_down; in.final_g = ap_->in.final_g; unsigned char* ws = ap_->ws; float* outp = ap_->out; (void)outp; \
    bf16_t* XN = (bf16_t*)(ws + WS_XN); bf16_t* CAT = XN; bf16_t* P = (bf16_t*)(ws + WS_P); bf16_t* Q = (bf16_t*)(ws + WS_Q); unsigned char* KV = ws + WS_KV; bf16_t* KR = (bf16_t*)(ws + WS_KR); \
    bf16_t* X1 = (bf16_t*)(ws + WS_X1); bf16_t* S = (bf16_t*)(ws + WS_S); bf16_t* YP = (bf16_t*)(ws + WS_YP); float* DEC = (float*)(ws + WS_DEC); \
    float* ROPE = (float*)(ws + WS_ROPE); float* RSQ = (float*)(ws + WS_RSQ); float* RSKV = (float*)(ws + WS_RSKV); float* RS2 = (float*)(ws + WS_RS2); \
    int* EID = (int*)(ws + WS_EID); float* EW = (float*)(ws + WS_EW); int* CNT = (int*)(ws + WS_CNT); int* SRC = (int*)(ws + WS_SRC); float* WGT = (float*)(ws + WS_WGT); int* TILEE = (int*)(ws + WS_TILEE); \
    bf16_t* HE = (bf16_t*)(ws + WS_HE); bf16_t* Y = (bf16_t*)(ws + WS_Y); const bf16_t* DFTW = (const bf16_t*)(ws + WS_DFTW); \
    (void)XN; (void)CAT; (void)P; (void)Q; (void)KV; (void)KR; (void)X1; (void)S; (void)YP; (void)DEC; (void)ROPE; (void)RSQ; (void)RSKV; (void)RS2; (void)EID; (void)EW; (void)CNT; (void)SRC; (void)WGT; (void)TILEE; (void)HE; (void)Y; (void)DFTW; \
    const int G = gridDim.x, bid = lbid(); (void)G; (void)bid;
    if (IN(1)) { PH_BEGIN REP(19) pro::tables_phase(in, ws);
        REP(20) { pro::weights_phase(lds, in, ws); __syncthreads(); }
        nrm::phase<false, false, false>(in.x, nullptr, nullptr, X1 + (size_t)T * DM  , in.norm1_g, nullptr, (float*)(ws + WS_RSN));
    } SEAM(1);

#pragma unroll 1
    for (int l = 0; l < DEPTH; ++l) {
        const int pb = 2 + 11 * l;
        if (l > 0) {
        if (IN(pb + 0)) { PH_BEGIN nrm::phase<true, false, true>(XN  , Y, nullptr, X1, in.norm1_g + (size_t)l * DM, nullptr, (float*)(ws + WS_RSN)); }
        SEAM(pb + 0);
        }
        if (IN(pb + 1)) { PH_BEGIN
            pg8::Gemm g{l == 0 ? X1 + (size_t)T * DM   : X1, (const bf16_t*)(ws + WS_WIN) + (size_t)l * PW * DM, DM, DM, DM}; pg8::StaticOrder so; so.init(T, PW, G, bid);
            epi::Store E{P, PW, (const float*)(ws + WS_RSN)};
            REP(1) { pg8::gemm_phase<epi::Store, pg8::StaticOrder, ALIGN_E, true>(lds, g, so, E); __syncthreads(); }
        }
        SEAM(pb + 1);
        if (IN(pb + 2)) { PH_BEGIN
#ifndef SUBMASK
#define SUBMASK 7
#endif
            if ((SUBMASK & 2) && !SKIP(1)) { gla::load_consts(lds, in.wa_f + (size_t)l * 2048, in.ba_f + l * 128, in.wa_b + (size_t)l * 2048, in.ba_b + l * 128, in.gla_ng + l * 64);
            REP(3) for (int c = bid; c < BATCH * NCHUNK; c += G) gla::g1_unit(lds, P, S, DEC, c, ROPE, RSQ, RSKV, (unsigned char*)KR); }
            __syncthreads();
            if ((SUBMASK & 4) && !SKIP(2)) REP(4) { fnet::phase<1>(lds, P, YP, DFTW, (const bf16_t*)(ws + WS_FM) + (size_t)l * 4 * 8192); __syncthreads(); }
        }
        SEAM(pb + 2);
        if (IN(pb + 3)) { PH_BEGIN
            if ((SUBMASK & 2) && !SKIP(4)) { pg8::Gemm g{P + PC_CQ, (const bf16_t*)(ws + WS_WUQ) + (size_t)l * QW * 256, 256, PW, 256}; pg8::StaticOrder so; so.init(T, QW, G, bid);
              epi::QRope E{(unsigned char*)Q, RSQ, ROPE};
              REP(5) { pg8::gemm_phase<epi::QRope, pg8::StaticOrder, ALIGN_E, true>(lds, g, so, E); __syncthreads(); } }
            __syncthreads();
            if ((SUBMASK & 4) && !SKIP(5)) { pg8::Gemm g{P + PC_CKV, (const bf16_t*)(ws + WS_WUKV) + (size_t)l * KVW * 128, 128, PW, 128}; pg8::StaticOrder so; so.init(T, KVW, G, bid);
              epi::StoreKV E{KV, ws + WS_K8, RSKV};
              REP(6) { pg8::gemm_phase<epi::StoreKV, pg8::StaticOrder, ALIGN_E, true>(lds, g, so, E); __syncthreads(); } }
            { const int nrem = ((T / 256) * (QW / 256)) % G; __syncthreads();
              if (nrem == 0) gla::g2_scan(lds, S, DEC, bid, G); else if (bid >= nrem) gla::g2_scan(lds, S, DEC, bid - nrem, G - nrem); }
        }
        SEAM(pb + 3);
        if (IN(pb + 4)) { PH_BEGIN att::vt_phase(lds, KV, ws + WS_V8T); }
        SEAM(pb + 4);
        if (IN(pb + 5)) { PH_BEGIN
            if ((SUBMASK & 1) && !SKIP(6)) { gla::load_consts(lds, in.wa_f + (size_t)l * 2048, in.ba_f + l * 128, in.wa_b + (size_t)l * 2048, in.ba_b + l * 128, in.gla_ng + l * 64);
            REP(7) for (int c = bid; c < BATCH * NCHUNK; c += G) gla::g3_unit(lds, P, S, CAT, c); }
            __syncthreads();
            if ((SUBMASK & 2) && !SKIP(7)) REP(8) { fnet::phase<2>(lds, YP, CAT, DFTW, nullptr); __syncthreads(); }
            __syncthreads();
            if ((SUBMASK & 4) && !SKIP(8)) REP(9) { att::attn_phase<0>((const unsigned char*)Q, KV, ws + WS_K8, (const unsigned char*)KR, ws + WS_V8T, CAT, lds); __syncthreads(); }
#ifdef ATT_PROBE2
            att::attn_phase<ATT_PROBE2>((const unsigned char*)Q, KV, ws + WS_K8, (const unsigned char*)KR, ws + WS_V8T, (bf16_t*)outp, lds); __syncthreads();
#endif
        }
        SEAM(pb + 5);
        if (IN(pb + 6)) { PH_BEGIN
            pg8::Gemm g{CAT, (const bf16_t*)(ws + WS_WOUT) + (size_t)l * DM * DM, DM, DM, DM}; pg8::StaticOrder so; so.init(T, DM, G, bid);
            epi::Store E{P  , DM, nullptr};
            REP(16) { pg8::gemm_phase<epi::Store, pg8::StaticOrder, ALIGN_E, true>(lds, g, so, E); __syncthreads(); }
        }
        SEAM(pb + 6);
        if (IN(pb + 7)) { PH_BEGIN
            if (l == 0) moe::route_phase<true>(lds, X1 + (size_t)T * DM  , P  , (const bf16_t*)(ws + WS_WR) + (size_t)l * 48 * DM, (const bf16_t*)(ws + WS_WR) + (size_t)(2 + l) * 48 * DM, in.b_rg + l * 4, in.b_re + l * 32, in.norm2_g + (size_t)l * DM, EID, EW, RS2, CNT, XN);
            else moe::route_phase<true>(lds, X1, P  , (const bf16_t*)(ws + WS_WR) + (size_t)l * 48 * DM, (const bf16_t*)(ws + WS_WR) + (size_t)(2 + l) * 48 * DM, in.b_rg + l * 4, in.b_re + l * 32, in.norm2_g + (size_t)l * DM, EID, EW, RS2, CNT, XN);
            __syncthreads();
            REP(11) pro::moe_weights_phase(lds, in, ws, l);
        }
        SEAM(pb + 7);
        if (IN(pb + 8)) { PH_BEGIN REP(12) moe::scatter_phase(lds, EID, EW, RS2, CNT, SRC, WGT, (int*)(ws + WS_ROWTOK), (float*)(ws + WS_RSS), TILEE); }
        SEAM(pb + 8);
        if (IN(pb + 9)) { PH_BEGIN
            const int ntile = ((const GAS int*)TILEE)[MT_MAX];
            unsigned* cntA = (unsigned*)(ws + WS_CTL + 57344) + l * 128; unsigned* cntB = cntA + 64;
            const int NGU = 2 * ntile, NL = NGU > 2 * G ? NGU - 2 * G : 0, ntE = ntile < G ? ntile : G;
            const int pbid = (G % 32 == 0) ? (4 * (8 * (bid >> 5) + (bid & 7)) + ((bid >> 3) & 3)) : bid;
            { pg8::Gemm g{XN, (const bf16_t*)(ws + WS_WGU), DM, DM, DM, (const int*)(ws + WS_ROWTOK)}; pg8::MoeOrderA mo{TILEE, ntile, G, pbid, cntA};
              epi::GateUp E{HE, (const float*)(ws + WS_RSS)};
              pg8::gemm_phase<epi::GateUp, pg8::MoeOrderA, ALIGN_E, true, true>(lds, g, mo, E); __syncthreads(); }
            const bool late = pbid < NL;
            if (late) { pg8::grid_arrive(cntB); pg8::grid_wait(cntB, (unsigned)NL); } else pg8::grid_wait(cntA, (unsigned)G);
            { pg8::Gemm g{HE, (const bf16_t*)(ws + WS_WD), DEXP, DEXP, DEXP};
              pg8::DownOrder dn{TILEE, late ? 4 * ntE + pbid : pbid - NL, late ? NL : G - NL, late ? 4 * ntile : 4 * ntE};
              epi::Down E{Y, SRC, WGT};
              pg8::gemm_phase<epi::Down, pg8::DownOrder, ALIGN_E, true>(lds, g, dn, E); __syncthreads(); }
        }
        SEAM(pb + 10);
    }
    if (IN(24)) { PH_BEGIN nrm::phase<true, true, true>(XN  , Y, nullptr, nullptr, in.final_g, nullptr, outp);
#ifdef SELFCHECK
        {
            __syncthreads(); VM_WAIT();
            const GAS float* met = (const GAS float*)(ws + WS_CTL + 49152); float m = 0.f;
            if (SELFCHECK < 0) { for (int i = 0; i < 8; ++i) m = fmaxf(m, met[i]); } else m = met[SELFCHECK];
            const float sc = 1.f + 10.f * m;
            const int gw = lbid() * 8 + (ltid() >> 6), NGW = gridDim.x * 8, lane = ltid() & 63;
            for (int t = gw; t < T; t += NGW) for (int k = 0; k < 16; ++k) ((GAS float*)outp)[(size_t)t * DM + lane + 64 * k] *= sc;
        }
#endif
    }
#undef IN
#undef SEAM
}

extern "C" void kernel_launch(void* const* d_in, const int* in_sizes, int n_in, void* d_out, int out_size, void* d_ws, size_t ws_size, hipStream_t stream) {
    static int grid = 0;
    if (grid == 0) {
        if (n_in != 24 || in_sizes[0] != T * DM || out_size != T * DM || ws_size < WS_END) { fprintf(stderr, "kernel_launch: shape / workspace mismatch (n_in %d, ws %zu < %zu?)\n", n_in, ws_size, (size_t)WS_END); grid = -1; return; }
        int dev = 0, cus = 0, per_cu = 0;
        if (hipGetDevice(&dev) != hipSuccess || hipDeviceGetAttribute(&cus, hipDeviceAttributeMultiprocessorCount, dev) != hipSuccess) { grid = -1; return; }
        if (hipFuncSetAttribute((const void*)fwd_kernel, hipFuncAttributeMaxDynamicSharedMemorySize, LDS_BYTES) != hipSuccess) { fprintf(stderr, "kernel_launch: hipFuncSetAttribute failed\n"); grid = -1; return; }
        if (hipOccupancyMaxActiveBlocksPerMultiprocessor(&per_cu, (const void*)fwd_kernel, NWAVES * 64, LDS_BYTES) != hipSuccess || per_cu < 1) { fprintf(stderr, "kernel_launch: occupancy query says %d\n", per_cu); }
        (void)hipGetLastError();
        grid = cus;
    }
    if (grid < 0) return;
    if (hipMemsetAsync((char*)d_ws + WS_CTL, 0, CTL_ZERO_BYTES, stream) != hipSuccess) return;
    Args a{};
    a.in.x = (const float*)d_in[0]; a.in.positions = (const int*)d_in[1]; a.in.norm1_g = (const float*)d_in[2]; a.in.w_in = (const float*)d_in[3];
    a.in.wa_f = (const float*)d_in[4]; a.in.ba_f = (const float*)d_in[5]; a.in.wa_b = (const float*)d_in[6]; a.in.ba_b = (const float*)d_in[7];
    a.in.gla_ng = (const float*)d_in[8]; a.in.fnet_w = (const float*)d_in[9]; a.in.qn_g = (const float*)d_in[10]; a.in.w_uq = (const float*)d_in[11];
    a.in.kvn_g = (const float*)d_in[12]; a.in.w_ukv = (const float*)d_in[13]; a.in.w_out = (const float*)d_in[14]; a.in.norm2_g = (const float*)d_in[15];
    a.in.w_rg = (const float*)d_in[16]; a.in.b_rg = (const float*)d_in[17]; a.in.w_re = (const float*)d_in[18]; a.in.b_re = (const float*)d_in[19];
    a.in.w_gate = (const float*)d_in[20]; a.in.w_up = (const float*)d_in[21]; a.in.w_down = (const float*)d_in[22]; a.in.final_g = (const float*)d_in[23];
    a.out = (float*)d_out; a.ws = (unsigned char*)d_ws;
#if defined(PREFIX_K)
#ifndef PREFIX_SKIP
#define PREFIX_SKIP 0
#endif
    a.ph_lo = 0; a.ph_hi = PREFIX_K; a.li = 0; a.pad = PREFIX_SKIP;
    hipLaunchKernelGGL(fwd_kernel, dim3(grid), dim3(NWAVES * 64), LDS_BYTES, stream, a);
    a.ph_lo = 0; a.ph_hi = N_PHASES; a.li = 1; a.pad = 0;
    hipLaunchKernelGGL(fwd_kernel, dim3(grid), dim3(NWAVES * 64), LDS_BYTES, stream, a);
#elif defined(SELFCHECK)
    a.ph_lo = 0; a.ph_hi = 8; a.li = 0;
    hipLaunchKernelGGL(fwd_kernel, dim3(grid), dim3(NWAVES * 64), LDS_BYTES, stream, a);
    hipLaunchKernelGGL(chk::check_kernel, dim3(chk::NS), dim3(256), 0, stream, a.in, (unsigned char*)d_ws);
    a.ph_lo = 8; a.ph_hi = N_PHASES; a.li = 1;
    hipLaunchKernelGGL(fwd_kernel, dim3(grid), dim3(NWAVES * 64), LDS_BYTES, stream, a);
#elif !defined(MK_SPLIT)
    a.ph_lo = 0; a.ph_hi = N_PHASES;
    hipLaunchKernelGGL(fwd_kernel, dim3(grid), dim3(NWAVES * 64), LDS_BYTES, stream, a);
#else
    for (int p = 0; p < N_PHASES; ++p) { a.ph_lo = p; a.ph_hi = p + 1; hipLaunchKernelGGL(fwd_kernel, dim3(grid), dim3(NWAVES * 64), LDS_BYTES, stream, a); }
#endif
    const hipError_t le = hipPeekAtLastError();
    if (le != hipSuccess) fprintf(stderr, "kernel_launch: launch failed: %s\n", hipGetErrorName(le));
}
```
